# Optimizing an MI355X kernel written in HIP

```python
import jax
import jax.numpy as jnp
from jax import lax
import numpy as np

D_MODEL = 1024
BATCH = 8
SEQ = 4096
DEPTH = 2

CTX_LEN = 256
GRID_W = 64
EPS = 1e-6

MLA_HEADS = 4
MLA_Q_RANK = 256
MLA_KV_RANK = 128
MLA_NOPE = 64
MLA_ROPE = 32
MLA_V = 64
ROPE_BASE = 10000.0
Q_BLOCK = 128

NA_HEADS = 4
NA_DIM = 64
NA_KR = 8
NA_KC = 16

ML_HEADS = 4
ML_QK = 64
ML_V = 128
ML_CHUNK = 128

N_EXPERTS = 16
D_EXPERT = 1024
EC_FACTOR = 2

MLA_W = MLA_HEADS * MLA_V
NA_W = NA_HEADS * NA_DIM
ML_W = ML_HEADS * ML_V

IN_SIZES = (MLA_Q_RANK, MLA_KV_RANK, MLA_ROPE,
            NA_W, NA_W, NA_W,
            ML_HEADS * ML_QK, ML_HEADS * ML_QK, ML_W, ML_W, 4 * ML_HEADS,
            3 * D_MODEL)
D_IN = sum(IN_SIZES)

kernel_name = 'hybrid_mla_natten_mlstm_ecmoe_diffusion'


def rmsnorm(x, g):
    xf = x.astype(jnp.float32)
    xf = xf * lax.rsqrt(jnp.mean(jnp.square(xf), axis=-1, keepdims=True) + EPS)
    return (xf * g.astype(jnp.float32)).astype(x.dtype)


def split_in(z):
    offs = np.cumsum(IN_SIZES)[:-1].tolist()
    return jnp.split(z, offs, axis=-1)


def rope_2d(n):
    t = jnp.arange(n)
    pos = jnp.stack([t // GRID_W, t % GRID_W], axis=-1).astype(jnp.float32)
    nf = MLA_ROPE // 4
    inv = ROPE_BASE ** (-jnp.arange(nf, dtype=jnp.float32) / nf)
    ang = pos[..., None] * inv
    return jnp.cos(ang), jnp.sin(ang)


def apply_rope_2d(x, cos, sin):
    xs = x.reshape(x.shape[:-1] + (2, 2, MLA_ROPE // 4))
    x1, x2 = xs[..., 0, :], xs[..., 1, :]
    cos, sin = cos.astype(x.dtype), sin.astype(x.dtype)
    out = jnp.stack([x1 * cos - x2 * sin, x1 * sin + x2 * cos], axis=-2)
    return out.reshape(x.shape)


def mla_queries(cq, g_q, w_uq, cos, sin):
    q = jnp.einsum('bnr,rhe->bnhe', rmsnorm(cq, g_q), w_uq)
    q_nope, q_rope = q[..., :MLA_NOPE], q[..., MLA_NOPE:]
    if cos is not None:
        q_rope = apply_rope_2d(q_rope, cos[:, None], sin[:, None])
    return jnp.concatenate([q_nope, q_rope], axis=-1)


def mla_keys_values(ckv, kr, g_kv, w_ukv, cos, sin):
    kv = jnp.einsum('bnr,rhe->bnhe', rmsnorm(ckv, g_kv), w_ukv)
    k_nope, v = kv[..., :MLA_NOPE], kv[..., MLA_NOPE:]
    if cos is not None:
        kr = apply_rope_2d(kr, cos, sin)
    k_rope = jnp.broadcast_to(kr[:, :, None, :], k_nope.shape[:3] + (MLA_ROPE,))
    return jnp.concatenate([k_nope, k_rope], axis=-1), v


def block_attention(q, k, v):
    B, n, H, E = q.shape
    scale = E ** -0.5
    qb = jnp.moveaxis(q.reshape(B, n // Q_BLOCK, Q_BLOCK, H, E), 1, 0)

    def one_block(q_blk):
        s = jnp.einsum('bqhe,bkhe->bhqk', q_blk, k).astype(jnp.float32) * scale
        p = jax.nn.softmax(s, axis=-1).astype(v.dtype)
        return jnp.einsum('bhqk,bkhv->bqhv', p, v)

    o = lax.map(one_block, qb)
    return jnp.moveaxis(o, 0, 1).reshape(B, n, H, v.shape[-1])


def neighbourhood_attention(q, k, v, k_ctx, v_ctx, rpb):
    B, n, H, d = q.shape
    rows = n // GRID_W
    kr = min(NA_KR, rows)
    scale = d ** -0.5
    grid = lambda t: t.reshape(B, rows, GRID_W, H, d)
    qg, kg, vg = grid(q), grid(k), grid(v)
    cols = jnp.arange(GRID_W)
    col_idx = jnp.clip(cols - NA_KC // 2, 0, GRID_W - NA_KC)[:, None] + jnp.arange(NA_KC)[None, :]
    dc = col_idx - cols[:, None]
    n_loc = kr * NA_KC

    def one_row(r):
        rs = jnp.clip(r - kr // 2, 0, rows - kr)
        q_r = lax.dynamic_index_in_dim(qg, r, axis=1, keepdims=False)
        k_win = lax.dynamic_slice_in_dim(kg, rs, kr, axis=1)[:, :, col_idx]
        v_win = lax.dynamic_slice_in_dim(vg, rs, kr, axis=1)[:, :, col_idx]
        dr = rs + jnp.arange(kr) - r
        bias = rpb[:, dr[:, None, None] + NA_KR - 1, dc[None] + NA_KC - 1]
        bias = jnp.transpose(bias, (0, 2, 1, 3)).reshape(H, GRID_W, n_loc).astype(jnp.float32)
        s_loc = jnp.einsum('bwhd,biwjhd->bhwij', q_r, k_win).reshape(B, H, GRID_W, n_loc)
        s_ctx = jnp.einsum('bwhd,bchd->bhwc', q_r, k_ctx)
        s = jnp.concatenate([s_loc.astype(jnp.float32) * scale + bias,
                             s_ctx.astype(jnp.float32) * scale], axis=-1)
        p = jax.nn.softmax(s, axis=-1).astype(v.dtype)
        p_loc = p[..., :n_loc].reshape(B, H, GRID_W, kr, NA_KC)
        return (jnp.einsum('bhwij,biwjhd->bwhd', p_loc, v_win)
                + jnp.einsum('bhwc,bchd->bwhd', p[..., n_loc:], v_ctx))

    o = lax.map(one_row, jnp.arange(rows))
    return jnp.moveaxis(o, 0, 1).reshape(B, n, H, d)


def mlstm_scan(q, k, v, i_pre, f_pre, state, with_out):
    B, H, n, _ = q.shape
    nc = n // ML_CHUNK
    chunks = lambda t: jnp.moveaxis(t.reshape((B, H, nc, ML_CHUNK) + t.shape[3:]), 2, 0)
    tri = jnp.tril(jnp.ones((ML_CHUNK, ML_CHUNK), dtype=bool))

    def step(carry, inp):
        C, nv, m = carry
        qc, kc, vc, ic, fc = inp
        b = jnp.cumsum(jax.nn.log_sigmoid(fc), axis=-1)
        bL = b[..., -1]
        w_log = bL[..., None] - b + ic
        m_new = jnp.maximum(bL + m, jnp.max(w_log, axis=-1))
        decay = jnp.exp(bL + m - m_new)
        w = jnp.exp(w_log - m_new[..., None])
        C_new = decay[..., None, None] * C + jnp.einsum('bhs,bhsv,bhsk->bhvk', w, vc, kc)
        n_new = decay[..., None] * nv + jnp.einsum('bhs,bhsk->bhk', w, kc)
        new = (C_new, n_new, m_new)
        if not with_out:
            return new, None
        d_log = jnp.where(tri, b[..., :, None] - b[..., None, :] + ic[..., None, :], -jnp.inf)
        inter = b + m[..., None]
        m_t = jnp.maximum(inter, jnp.max(d_log, axis=-1))
        a = jnp.exp(inter - m_t)
        s = jnp.einsum('bhtk,bhsk->bhts', qc, kc) * jnp.exp(d_log - m_t[..., None])
        num = a[..., None] * jnp.einsum('bhvk,bhtk->bhtv', C, qc) + jnp.einsum('bhts,bhsv->bhtv', s, vc)
        den = a * jnp.einsum('bhk,bhtk->bht', nv, qc) + jnp.sum(s, axis=-1)
        h = num / jnp.maximum(jnp.abs(den), jnp.exp(-m_t))[..., None]
        return new, h

    state, hs = lax.scan(step, state, (chunks(q), chunks(k), chunks(v), chunks(i_pre), chunks(f_pre)))
    if not with_out:
        return state, None
    return state, jnp.moveaxis(hs, 0, 2).reshape(B, H, n, ML_V)


def mlstm_bidir(mq, mk, mv, mg, mq_c, mk_c, mv_c, mg_c, b_ml, ctx_out):
    def prep(q, k, v, g):
        B, n, _ = q.shape
        th = lambda t, dd: jnp.transpose(t.reshape(B, n, ML_HEADS, dd), (0, 2, 1, 3)).astype(jnp.float32)
        gates = jnp.transpose((g + b_ml).astype(jnp.float32).reshape(B, n, 4, ML_HEADS), (2, 0, 3, 1))
        return th(q, ML_QK), th(k, ML_QK) * (ML_QK ** -0.5), th(v, ML_V), gates

    q, k, v, g = prep(mq, mk, mv, mg)
    qc, kc, vc, gc = prep(mq_c, mk_c, mv_c, mg_c)
    B = q.shape[0]
    zero = (jnp.zeros((B, ML_HEADS, ML_V, ML_QK), jnp.float32),
            jnp.zeros((B, ML_HEADS, ML_QK), jnp.float32),
            jnp.zeros((B, ML_HEADS), jnp.float32))
    fl = lambda t: jnp.flip(t, axis=2)
    s_f, hc_f = mlstm_scan(qc, kc, vc, gc[0], gc[1], zero, ctx_out)
    _, h_f = mlstm_scan(q, k, v, g[0], g[1], s_f, True)
    s_b, hc_b = mlstm_scan(fl(qc), fl(kc), fl(vc), fl(gc[2]), fl(gc[3]), zero, ctx_out)
    _, h_b = mlstm_scan(fl(q), fl(k), fl(v), fl(g[2]), fl(g[3]), s_b, True)
    h = jnp.transpose(h_f + fl(h_b), (0, 2, 1, 3))
    if not ctx_out:
        return h, None
    return h, jnp.transpose(hc_f + fl(hc_b), (0, 2, 1, 3))


def mlstm_output(h, o, g_ml):
    hn = rmsnorm(h, g_ml.reshape(ML_HEADS, ML_V)).reshape(o.shape[:2] + (ML_W,))
    return hn.astype(o.dtype) * jax.nn.sigmoid(o)


def merge(a, b, m, gates, w_br_mla, w_br_na, w_br_ml, w_out):
    g_a, g_b, g_m = jnp.split(jax.nn.sigmoid(gates), 3, axis=-1)
    flat = lambda t: t.reshape(t.shape[:2] + (-1,))
    y = g_a * (flat(a) @ w_br_mla) + g_b * (flat(b) @ w_br_na) + g_m * (m @ w_br_ml)
    return y @ w_out


def token_mixers(h, hc, w_in, g_q, g_kv, w_uq, w_ukv, rpb, b_ml, g_ml,
                 w_br_mla, w_br_na, w_br_ml, w_out, ctx_out):
    n = h.shape[1]
    (cq, ckv, kr, nq, nk, nv, mq, mk, mv, mo, mg, bg) = split_in(h @ w_in)
    (cq_c, ckv_c, kr_c, nq_c, nk_c, nv_c, mq_c, mk_c, mv_c, mo_c, mg_c, bg_c) = split_in(hc @ w_in)
    cos, sin = rope_2d(n)
    k_c, v_c = mla_keys_values(ckv_c, kr_c, g_kv, w_ukv, None, None)
    k_l, v_l = mla_keys_values(ckv, kr, g_kv, w_ukv, cos, sin)
    a = block_attention(mla_queries(cq, g_q, w_uq, cos, sin),
                        jnp.concatenate([k_c, k_l], axis=1), jnp.concatenate([v_c, v_l], axis=1))
    nh = lambda t: t.reshape(t.shape[:2] + (NA_HEADS, NA_DIM))
    b = neighbourhood_attention(nh(nq), nh(nk), nh(nv), nh(nk_c), nh(nv_c), rpb)
    m, m_c = mlstm_bidir(mq, mk, mv, mg, mq_c, mk_c, mv_c, mg_c, b_ml, ctx_out)
    y = merge(a, b, mlstm_output(m, mo, g_ml), bg, w_br_mla, w_br_na, w_br_ml, w_out)
    if not ctx_out:
        return y, None
    a_c = block_attention(mla_queries(cq_c, g_q, w_uq, None, None), k_c, v_c)
    b_c = block_attention(nh(nq_c), nh(nk_c), nh(nv_c))
    y_c = merge(a_c, b_c, mlstm_output(m_c, mo_c, g_ml), bg_c, w_br_mla, w_br_na, w_br_ml, w_out)
    return y, y_c


def expert_choice_ffn(h, w_router, w1, w3, w2):
    B, n, _ = h.shape
    cap = EC_FACTOR * n // N_EXPERTS
    aff = jax.nn.softmax((h @ w_router).astype(jnp.float32), axis=-1)
    g, idx = lax.top_k(jnp.swapaxes(aff, 1, 2), cap)
    bidx = jnp.arange(B)[:, None, None]
    xs = h[bidx, idx]
    hid = jax.nn.silu(jnp.einsum('becd,edf->becf', xs, w1)) * jnp.einsum('becd,edf->becf', xs, w3)
    y = jnp.einsum('becf,efd->becd', hid, w2) * g[..., None].astype(h.dtype)
    return jnp.zeros_like(h).at[bidx, idx].add(y)


def setup_inputs(seed: int = 0) -> dict:
    key = jax.random.key(seed)
    ks = iter(jax.random.split(key, 32))
    nrm = lambda shape, scale: jax.random.normal(next(ks), shape, jnp.float32) * scale
    L, D = DEPTH, D_MODEL
    f_bias = jnp.linspace(3.0, 6.0, ML_HEADS)
    gate_base = jnp.concatenate([jnp.zeros(ML_HEADS), f_bias, jnp.zeros(ML_HEADS), f_bias])
    return {
        'x': nrm((BATCH, SEQ, D), 1.0),
        'c': nrm((BATCH, D), 1.0),
        'ctx': nrm((BATCH, CTX_LEN, D), 1.0),
        'c_ctx': nrm((D,), 1.0),
        'w_mod': nrm((L, D, 6 * D), 0.5 * D ** -0.5),
        'b_mod': nrm((L, 6 * D), 0.02),
        'g_pre1': 1.0 + nrm((L, D), 0.02),
        'g_post1': 1.0 + nrm((L, D), 0.02),
        'g_pre2': 1.0 + nrm((L, D), 0.02),
        'g_post2': 1.0 + nrm((L, D), 0.02),
        'w_in': nrm((L, D, D_IN), D ** -0.5),
        'g_q': 1.0 + nrm((L, MLA_Q_RANK), 0.02),
        'g_kv': 1.0 + nrm((L, MLA_KV_RANK), 0.02),
        'w_uq': nrm((L, MLA_Q_RANK, MLA_HEADS, MLA_NOPE + MLA_ROPE), MLA_Q_RANK ** -0.5),
        'w_ukv': nrm((L, MLA_KV_RANK, MLA_HEADS, MLA_NOPE + MLA_V), MLA_KV_RANK ** -0.5),
        'rpb': nrm((L, NA_HEADS, 2 * NA_KR - 1, 2 * NA_KC - 1), 0.1),
        'b_ml_gates': gate_base + nrm((L, 4 * ML_HEADS), 0.1),
        'g_ml': 1.0 + nrm((L, ML_W), 0.02),
        'w_br_mla': nrm((L, MLA_W, D), MLA_W ** -0.5),
        'w_br_na': nrm((L, NA_W, D), NA_W ** -0.5),
        'w_br_ml': nrm((L, ML_W, D), ML_W ** -0.5),
        'w_out': nrm((L, D, D), D ** -0.5),
        'w_router': nrm((L, D, N_EXPERTS), D ** -0.5),
        'w_e1': nrm((L, N_EXPERTS, D, D_EXPERT), D ** -0.5),
        'w_e3': nrm((L, N_EXPERTS, D, D_EXPERT), D ** -0.5),
        'w_e2': nrm((L, N_EXPERTS, D_EXPERT, D), D_EXPERT ** -0.5),
    }


def reference(x, c, ctx, c_ctx, w_mod, b_mod, g_pre1, g_post1, g_pre2, g_post2, w_in, g_q, g_kv,
              w_uq, w_ukv, rpb, b_ml_gates, g_ml, w_br_mla, w_br_na, w_br_ml, w_out,
              w_router, w_e1, w_e3, w_e2):
    xc = ctx
    for l in range(DEPTH):
        ctx_out = l < DEPTH - 1
        mod = jax.nn.silu(c) @ w_mod[l] + b_mod[l]
        mod_c = jax.nn.silu(c_ctx) @ w_mod[l] + b_mod[l]
        sh1, sc1, gt1, sh2, sc2, gt2 = jnp.split(mod[:, None, :], 6, axis=-1)
        shc1, scc1, gtc1, shc2, scc2, gtc2 = jnp.split(mod_c, 6, axis=-1)
        h = rmsnorm(x, g_pre1[l]) * (1.0 + sc1) + sh1
        hc = rmsnorm(xc, g_pre1[l]) * (1.0 + scc1) + shc1
        y, y_c = token_mixers(h, hc, w_in[l], g_q[l], g_kv[l], w_uq[l], w_ukv[l], rpb[l],
                              b_ml_gates[l], g_ml[l], w_br_mla[l], w_br_na[l], w_br_ml[l],
                              w_out[l], ctx_out)
        x = x + gt1 * rmsnorm(y, g_post1[l])
        h2 = rmsnorm(x, g_pre2[l]) * (1.0 + sc2) + sh2
        x = x + gt2 * rmsnorm(expert_choice_ffn(h2, w_router[l], w_e1[l], w_e3[l], w_e2[l]), g_post2[l])
        if ctx_out:
            xc = xc + gtc1 * rmsnorm(y_c, g_post1[l])
            hc2 = rmsnorm(xc, g_pre2[l]) * (1.0 + scc2) + shc2
            xc = xc + gtc2 * rmsnorm(expert_choice_ffn(hc2, w_router[l], w_e1[l], w_e3[l], w_e2[l]), g_post2[l])
    return x
```

```cpp
#include <hip/hip_runtime.h>
#include <cstdio>
#include <cstdint>

#define LAS __attribute__((address_space(3)))
#define DI __device__ __forceinline__
typedef unsigned short bf16_t;
typedef short bf16x8 __attribute__((ext_vector_type(8)));
typedef short s16x4 __attribute__((ext_vector_type(4)));
typedef float f32x2 __attribute__((ext_vector_type(2)));
typedef float f32x4 __attribute__((ext_vector_type(4)));
typedef float f32x16 __attribute__((ext_vector_type(16)));
typedef unsigned u32x2 __attribute__((ext_vector_type(2)));
typedef unsigned u32x4 __attribute__((ext_vector_type(4)));
typedef __bf16 bf16x2_t __attribute__((ext_vector_type(2)));

#ifndef MK_PER_PHASE
#define MK_PER_PHASE 0
#endif
#ifndef PH_MASK
#define PH_MASK 0xFFFFu
#endif
#define PHON(i) ((PH_MASK >> (i)) & 1u)

constexpr int NB = 8, SEQ = 4096, DM = 1024, CTX = 256;
constexpr int NL = NB * SEQ, NC = NB * CTX, NT = NL + NC;
constexpr int KEYS = SEQ + CTX;
constexpr int DIN = 5808;
constexpr float EPS = 1e-6f;
constexpr float LOG2E = 1.4426950408889634f;
constexpr int NCHUNK = 34;
constexpr int NPHASE = 28;

constexpr size_t MiB = 1u << 20;
constexpr size_t WS_CTL = 0, CTL_ZERO_BYTES = 64 * 1024;
constexpr size_t WS_MOD = 1 * MiB;
constexpr size_t WS_ROPE = WS_MOD + 512 * 1024;
constexpr size_t WS_SW = 2 * MiB, SW_STRIDE = 17 * MiB;
constexpr size_t SW_WIN = 0, SW_WQKV = 11 * MiB + 512 * 1024, SW_WA = SW_WQKV + 768 * 1024, SW_WB = SW_WA + 512 * 1024, SW_WM = SW_WB + 512 * 1024, SW_WOUT = SW_WM + MiB;
constexpr size_t WS_XC = 36 * MiB;
constexpr size_t WS_MISC = 44 * MiB;
constexpr size_t WS_AFF = WS_MISC, WS_AFFC = WS_MISC + 2 * MiB, WS_IDX = WS_AFFC + 256 * 1024, WS_IDXC = WS_IDX + 256 * 1024, WS_INV = WS_MISC + 2 * MiB + 768 * 1024, WS_INVC = WS_INV + MiB;
constexpr size_t WS_R = 48 * MiB;
constexpr size_t WS_KBUF = WS_R;
constexpr size_t WS_NK = WS_KBUF + 25 * MiB + 512 * 1024;
constexpr size_t WS_NVT = WS_NK + 17 * MiB;
constexpr size_t WS_MQ = WS_NVT + 17 * MiB;
constexpr size_t WS_MK = WS_MQ + 17 * MiB;
constexpr size_t WS_MKT = WS_MK + 17 * MiB;
constexpr size_t WS_MVT = WS_MKT + 17 * MiB;
constexpr size_t WS_STC = WS_MVT + 34 * MiB;
constexpr size_t WS_STN = WS_STC + 34 * MiB;
constexpr size_t WS_SC = WS_STN + 640 * 1024;
constexpr size_t WS_MS = WS_SC + 64 * 1024;
constexpr size_t WS_HBUF = WS_R + 180 * MiB;
constexpr size_t WS_Q = WS_HBUF;
constexpr size_t WS_VT = WS_HBUF + 26 * MiB;
constexpr size_t WS_CQKV = WS_HBUF + 68 * MiB;
constexpr size_t WS_GATES = WS_CQKV + 25 * MiB + 512 * 1024;
constexpr size_t WS_NQ = WS_GATES + 2 * MiB + 512 * 1024;
constexpr size_t WS_MO = WS_NQ + 17 * MiB;
constexpr size_t WS_BG = WS_MO + 34 * MiB;
constexpr size_t WS_END = WS_BG + 204 * MiB;
constexpr size_t WS_P = WS_R;
constexpr size_t WS_YO = WS_BG;
constexpr size_t WS_W13 = WS_R, WS_W2 = WS_R + 64 * MiB;
constexpr size_t WS_XS = WS_CQKV, WS_HID = WS_XS + 136 * MiB;
static_assert(WS_MS + 64 * 1024 <= WS_HBUF && WS_VT + 17 * MiB <= WS_CQKV && WS_P + 204 * MiB <= WS_CQKV && WS_HID + 136 * MiB <= WS_END && WS_W2 + 32 * MiB <= WS_HBUF, "ws map");
constexpr int CW_BAR = 1024;

DI unsigned cvtpk(float lo, float hi) { f32x2 v = {lo, hi}; bf16x2_t b = __builtin_convertvector(v, bf16x2_t); return __builtin_bit_cast(unsigned, b); }
DI float bflo(unsigned w) { return __uint_as_float(w << 16); }
DI float bfhi(unsigned w) { return __uint_as_float(w & 0xffff0000u); }
DI float bf2f(bf16_t b) { return __uint_as_float(((unsigned)b) << 16); }
DI bf16_t f2bf(float f) { return (bf16_t)(cvtpk(f, 0.f) & 0xffffu); }
DI bf16x8 pack8(float a0, float a1, float a2, float a3, float a4, float a5, float a6, float a7) {
    u32x4 p; p.x = cvtpk(a0, a1); p.y = cvtpk(a2, a3); p.z = cvtpk(a4, a5); p.w = cvtpk(a6, a7); return __builtin_bit_cast(bf16x8, p); }
DI int crow(int i, int hh) { return (i & 3) + 8 * (i >> 2) + 4 * hh; }
DI float shx(float v, int o, int lane) { return __int_as_float(__builtin_amdgcn_ds_bpermute((lane ^ o) << 2, __float_as_int(v))); }
DI unsigned shxu(unsigned v, int o, int lane) { return (unsigned)__builtin_amdgcn_ds_bpermute((lane ^ o) << 2, (int)v); }
DI float shup(float v, int o, int lane) { const int src = lane >= o ? lane - o : lane; return __int_as_float(__builtin_amdgcn_ds_bpermute(src << 2, __float_as_int(v))); }
DI unsigned shupu(unsigned v, int o, int lane) { const int src = lane >= o ? lane - o : lane; return (unsigned)__builtin_amdgcn_ds_bpermute(src << 2, (int)v); }
DI float shidx(float v, int src) { return __int_as_float(__builtin_amdgcn_ds_bpermute(src << 2, __float_as_int(v))); }
DI float wave_sum(float v, int lane) {
#pragma unroll
    for (int o = 1; o < 64; o <<= 1) v += shx(v, o, lane);
    return v; }
DI float wave_max(float v, int lane) {
#pragma unroll
    for (int o = 1; o < 64; o <<= 1) v = fmaxf(v, shx(v, o, lane));
    return v; }
DI float sigmoidf_(float x) { return 1.f / (1.f + __expf(-x)); }
DI float ex2(float x) { return __builtin_amdgcn_exp2f(x); }
#define MFMA32(a, b, c) __builtin_amdgcn_mfma_f32_32x32x16_bf16((a), (b), (c), 0, 0, 0)

namespace pg8 {
constexpr int BM = 256, BK = 64, HALF = 128, HTB = HALF * BK * 2, STAGE_BYTES = 8 * HTB, NXCD = 8, WGM = 8;
__host__ __device__ __forceinline__ int lds_byte(int r, int c) { const int st = (r >> 4) * 2 + (c >> 5), rr = r & 15, cc = c & 31, ob = rr * 64 + cc * 2; return st * 1024 + (ob ^ (((ob >> 9) & 1) << 5)); }
__host__ __device__ __forceinline__ void stage_rc(int b, int& R, int& C) { const int st = b / 1024, sb = b % 1024, swz = sb ^ (((sb >> 9) & 1) << 5); R = (st >> 1) * 16 + swz / 64; C = (st & 1) * 32 + (swz % 64) / 2; }
__host__ __device__ __forceinline__ int perm32(int rho) { const int n = rho >> 4, i = rho & 15; return 8 * (i >> 2) + 4 * n + (i & 3); }

struct Unit { int pm, pn; const char* a; const char* b; };
struct Gemm { int lda, ldb, K; };

struct Order {
    int nM, nN, nwg, G, c, moe; const char* A; const char* B; size_t astep, bstep;
    __device__ void init(int nM_, int nN_, int G_, int c_, const void* A_, int lda, const void* B_, int ldb, int moe_) {
        nM = nM_; nN = nN_; nwg = nM * nN; G = G_; c = c_; moe = moe_; A = (const char*)A_; B = (const char*)B_; astep = (size_t)256 * lda * 2; bstep = (size_t)256 * ldb * 2; }
    __device__ bool next(int i, Unit& u) const {
        const long L = (long)i * G + c; if (L >= nwg) return false;
        int wgid = (int)L; { const int q = nwg / NXCD, r = nwg % NXCD, xcd = wgid % NXCD, off = wgid / NXCD; wgid = (xcd < r ? xcd * (q + 1) : r * (q + 1) + (xcd - r) * q) + off; }
        const int nig = WGM * nN, gid = wgid / nig, fm = gid * WGM, gsz = (nM - fm) < WGM ? (nM - fm) : WGM;
        u.pm = fm + ((wgid % nig) % gsz); u.pn = (wgid % nig) / gsz;
        u.a = A + (size_t)u.pm * astep;
        int bt = u.pn; if (moe) { const int e = u.pm < 256 ? (u.pm >> 4) : (u.pm - 256); bt += e * nN; }
        u.b = B + (size_t)bt * bstep; return true;
    }
};

template <class Epi, class Sched, bool ALIGN_EPI>
__device__ __forceinline__ void gemm_phase(LAS unsigned char* lds, const Gemm g, const Sched& S, const Epi& E, const int tid) {
    const int wid = __builtin_amdgcn_readfirstlane(tid >> 6), lane = tid & 63, wr = wid >> 2, wc = wid & 3, fr = lane & 15, fq = lane >> 4;
    const int nt = g.K / BK;
    unsigned voffA[2], voffB[2];
#pragma unroll
    for (int i = 0; i < 2; ++i) { int R, C; stage_rc(tid * 16 + i * 8192, R, C); const int Rb = (R & ~31) + perm32(R & 31);
        voffA[i] = (unsigned)(R * g.lda + C) * 2u; voffB[i] = (unsigned)(Rb * g.ldb + C) * 2u; }
    const size_t kstep = (size_t)(BK * 2);
    const size_t hstepA = (size_t)HALF * g.lda * 2, hstepB = (size_t)HALF * g.ldb * 2;
    const unsigned ldsw = (unsigned)wid * 1024u;
    const int aoff = lds_byte(wr * 64 + fr, fq * 8), boff = lds_byte(wc * 32 + fr, fq * 8);
#define PG8_SA(b, h) (((b) * 2 + (h)) * HTB)
#define PG8_SB(b, h) ((4 + (b) * 2 + (h)) * HTB)
#define PG8_STAGE(bufoff, gbase, voff) do { _Pragma("unroll") for (int _i = 0; _i < 2; ++_i) \
        __builtin_amdgcn_global_load_lds((const unsigned*)((const char*)(gbase) + (voff)[_i]), (LAS unsigned*)(lds + (bufoff) + ldsw + _i * 8192), 16, 0, 0); } while (0)
#define PG8_LDA(dst, b, h) do { _Pragma("unroll") for (int m = 0; m < 4; ++m) _Pragma("unroll") for (int k = 0; k < 2; ++k) dst[m][k] = *(const LAS bf16x8*)(lds + PG8_SA(b, h) + aoff + m * 2048 + k * 1024); } while (0)
#define PG8_LDB(dst, b, h) do { _Pragma("unroll") for (int n = 0; n < 2; ++n) _Pragma("unroll") for (int k = 0; k < 2; ++k) dst[n][k] = *(const LAS bf16x8*)(lds + PG8_SB(b, h) + boff + n * 2048 + k * 1024); } while (0)
#define PG8_MMA(ai, bj, At, Bt) do { __builtin_amdgcn_s_setprio(1); _Pragma("unroll") for (int m = 0; m < 4; ++m) _Pragma("unroll") for (int n = 0; n < 2; ++n) _Pragma("unroll") for (int k = 0; k < 2; ++k) \
        acc[ai][bj][m][n] = __builtin_amdgcn_mfma_f32_16x16x32_bf16(Bt[n][k], At[m][k], acc[ai][bj][m][n], 0, 0, 0); __builtin_amdgcn_s_setprio(0); } while (0)
#define PG8_WAIT_V(n) asm volatile("s_waitcnt vmcnt(" #n ")" ::: "memory")
#define PG8_WAIT_L(n) asm volatile("s_waitcnt lgkmcnt(" #n ")" ::: "memory")
#define PG8_BAR __builtin_amdgcn_s_barrier()
#define PG8_SCHED __builtin_amdgcn_sched_barrier(0)
    Unit cur, nxt; int ui = 0;
    if (!S.next(0, cur)) return;
    f32x4 acc[2][2][4][2];
#pragma unroll
    for (int a = 0; a < 2; ++a)
#pragma unroll
        for (int b = 0; b < 2; ++b)
#pragma unroll
            for (int m = 0; m < 4; ++m)
#pragma unroll
                for (int n = 0; n < 2; ++n) acc[a][b][m][n] = (f32x4){0.f, 0.f, 0.f, 0.f};
    bf16x8 At[4][2], B0[2][2], B1[2][2];
    const char* cA = cur.a; const char* cB = cur.b;
    PG8_STAGE(PG8_SB(0, 0), cB, voffB); PG8_STAGE(PG8_SB(0, 1), cB + hstepB, voffB); PG8_STAGE(PG8_SA(0, 0), cA, voffA); PG8_STAGE(PG8_SA(0, 1), cA + hstepA, voffA);
    if (wr == 1) PG8_BAR;
    PG8_WAIT_V(2); PG8_BAR;
    PG8_STAGE(PG8_SB(1, 0), cB + kstep, voffB); PG8_STAGE(PG8_SA(1, 0), cA + kstep, voffA); PG8_STAGE(PG8_SB(1, 1), cB + hstepB + kstep, voffB);
    PG8_WAIT_V(6); PG8_BAR;
    for (;;) {
        const bool has_next = S.next(ui + 1, nxt);
        const char* nA = has_next ? nxt.a : cA; const char* nB = has_next ? nxt.b : cB;
#pragma unroll 1
        for (int t = 0; t < nt; t += 2) {
            const bool last = (t == nt - 2);
            const char* a1 = cA + (size_t)(t + 1) * kstep;
            const char* a2 = last ? nA : cA + (size_t)(t + 2) * kstep; const char* b2 = last ? nB : cB + (size_t)(t + 2) * kstep;
            const char* a3 = a2 + kstep; const char* b3 = b2 + kstep;
            PG8_LDB(B0, 0, 0); PG8_LDB(B1, 0, 1); PG8_SCHED; PG8_LDA(At, 0, 0); PG8_STAGE(PG8_SA(1, 1), a1 + hstepA, voffA);
            PG8_WAIT_V(8); PG8_WAIT_L(0); PG8_BAR; PG8_MMA(0, 0, At, B0); PG8_MMA(0, 1, At, B1); PG8_BAR; PG8_SCHED;
            PG8_LDA(At, 0, 1); PG8_STAGE(PG8_SB(0, 0), b2, voffB); PG8_STAGE(PG8_SB(0, 1), b2 + hstepB, voffB); PG8_STAGE(PG8_SA(0, 0), a2, voffA);
            PG8_WAIT_V(8); PG8_WAIT_L(0); PG8_BAR; PG8_MMA(1, 0, At, B0); PG8_MMA(1, 1, At, B1); PG8_BAR; PG8_SCHED;
            PG8_LDB(B0, 1, 0); PG8_LDB(B1, 1, 1); PG8_SCHED; PG8_LDA(At, 1, 0); PG8_STAGE(PG8_SA(0, 1), a2 + hstepA, voffA);
            PG8_WAIT_V(8); PG8_WAIT_L(0); PG8_BAR; PG8_MMA(0, 0, At, B0); PG8_MMA(0, 1, At, B1); PG8_BAR; PG8_SCHED;
            PG8_LDA(At, 1, 1); PG8_STAGE(PG8_SB(1, 0), b3, voffB); PG8_STAGE(PG8_SB(1, 1), b3 + hstepB, voffB); PG8_STAGE(PG8_SA(1, 0), a3, voffA);
            PG8_WAIT_V(8); PG8_WAIT_L(0); PG8_BAR; PG8_MMA(1, 0, At, B0); PG8_MMA(1, 1, At, B1); PG8_BAR; PG8_SCHED;
        }
        if constexpr (ALIGN_EPI) { if (wr == 0) PG8_BAR; }
        E(acc, cur, wr, wc, fr, fq);
        if (!has_next) break;
#pragma unroll
        for (int a = 0; a < 2; ++a)
#pragma unroll
            for (int b = 0; b < 2; ++b)
#pragma unroll
                for (int m = 0; m < 4; ++m)
#pragma unroll
                    for (int n = 0; n < 2; ++n) acc[a][b][m][n] = (f32x4){0.f, 0.f, 0.f, 0.f};
        cur = nxt; cA = nA; cB = nB; ++ui;
        if constexpr (ALIGN_EPI) { if (wr == 1) PG8_BAR; }
    }
    PG8_WAIT_V(0);
    if constexpr (!ALIGN_EPI) { if (wr == 0) PG8_BAR; }
    PG8_BAR;
#undef PG8_SA
#undef PG8_SB
#undef PG8_STAGE
#undef PG8_LDA
#undef PG8_LDB
#undef PG8_MMA
#undef PG8_WAIT_V
#undef PG8_WAIT_L
#undef PG8_BAR
#undef PG8_SCHED
}
}

#define XB_TMO      128
#define XB_XCNT(j)  (256  + 64 * (j))
#define XB_XSUB(j)  (1280 + 64 * (j))
#define XB_XGEN(j)  (2304 + 64 * (j))
#define XB_TOP      3328
#define XB_TOPGEN   3392
#define XCD_BAR_WORDS 3456
#define XB_SPIN_CAP (1u << 22)
DI unsigned xb_ld(unsigned* p)              { return __hip_atomic_load(p, __ATOMIC_RELAXED, __HIP_MEMORY_SCOPE_AGENT); }
DI unsigned xb_add(unsigned* p, unsigned v) { return __hip_atomic_fetch_add(p, v, __ATOMIC_RELAXED, __HIP_MEMORY_SCOPE_AGENT); }
DI unsigned xb_xcc_id() { return (unsigned)__builtin_amdgcn_s_getreg((3 << 11) | 20) & 0xFu; }
#define XB_SPIN(cond, bar) do { unsigned _sp = 0; while (cond) { __builtin_amdgcn_s_sleep(1); \
    if ((++_sp & 255u) == 0u) { if (xb_ld(&(bar)[XB_TMO])) break; if (_sp > XB_SPIN_CAP) { atomicAdd(&(bar)[XB_TMO], 1u); break; } } } } while (0)
struct XcdBarrier { unsigned* bar; unsigned x; volatile LAS unsigned* st; };
DI XcdBarrier xcd_barrier_post(unsigned* bar, volatile LAS unsigned* st) {
    XcdBarrier b; b.bar = bar; b.x = xb_xcc_id(); b.st = st;
    if (threadIdx.x == 0) (void)xb_add(&bar[XB_XCNT(b.x)], 1u);
    return b;
}
DI void xcd_barrier_complete(unsigned* bar, unsigned x, unsigned& nloc, unsigned& nx) {
    const unsigned G = gridDim.x * gridDim.y * gridDim.z;
    unsigned sum, cnt, mine, sp = 0u;
    for (;;) {
        sum = 0u; cnt = 0u; mine = 0u;
#pragma unroll
        for (unsigned j = 0; j < 16; ++j) { const unsigned c = xb_ld(&bar[XB_XCNT(j)]); sum += c; cnt += (c > 0u) ? 1u : 0u; mine = (j == x) ? c : mine; }
        if (sum == G) break;
        __builtin_amdgcn_s_sleep(1);
        if ((++sp & 255u) == 0u) { if (xb_ld(&bar[XB_TMO])) break; if (sp > XB_SPIN_CAP) { atomicAdd(&bar[XB_TMO], 1u); break; } }
    }
    nloc = mine > 0u ? mine : 1u; nx = cnt > 0u ? cnt : 1u;
}
DI void xcd_barrier(const XcdBarrier& b) {
    asm volatile("s_waitcnt vmcnt(0)" ::: "memory");
    __syncthreads();
    if (threadIdx.x == 0) {
        unsigned* bar = b.bar;
        __builtin_amdgcn_s_waitcnt(0);
        unsigned nloc = b.st[0], nx = b.st[1];
        if (nloc == 0u) { xcd_barrier_complete(bar, b.x, nloc, nx); b.st[0] = nloc; b.st[1] = nx; }
        const unsigned old = xb_add(&bar[XB_XSUB(b.x)], 1u);
        const unsigned gen = old / nloc;
        if (old + 1u == (gen + 1u) * nloc) {
            __builtin_amdgcn_fence(__ATOMIC_RELEASE, "agent");
            asm volatile("s_waitcnt vmcnt(0)" ::: "memory");
            const unsigned og = xb_add(&bar[XB_TOP], 1u);
            const unsigned tg = og / nx;
            if (og + 1u == (tg + 1u) * nx) xb_add(&bar[XB_TOPGEN], 1u);
            else XB_SPIN(xb_ld(&bar[XB_TOPGEN]) == tg, bar);
            __builtin_amdgcn_fence(__ATOMIC_ACQUIRE, "agent");
            xb_add(&bar[XB_XGEN(b.x)], 1u);
            asm volatile("s_waitcnt vmcnt(0)" ::: "memory");
        } else {
            XB_SPIN(xb_ld(&bar[XB_XGEN(b.x)]) == gen, bar);
            __builtin_amdgcn_fence(__ATOMIC_ACQUIRE, "agent");
            asm volatile("s_waitcnt vmcnt(0)" ::: "memory");
        }
    }
    __syncthreads();
}

struct Params { const float* in[26]; float* out; unsigned char* ws; int ph_lo, ph_hi; };
enum { I_X = 0, I_C, I_CTX, I_CCTX, I_WMOD, I_BMOD, I_GPRE1, I_GPOST1, I_GPRE2, I_GPOST2, I_WIN, I_GQ, I_GKV, I_WUQ, I_WUKV, I_RPB, I_BML, I_GML, I_WBRA, I_WBRB, I_WBRM, I_WOUT, I_WR, I_WE1, I_WE3, I_WE2 };

struct Ctx {
    const float* const* in; float* out; unsigned char* ws; LAS unsigned char* lds;
    int tid, lane, wave, vcu, G;
};
template <class T> DI T* wsp(const Ctx& c, size_t off) { return (T*)(c.ws + off); }
DI int row_batch(int r) { return r < NL ? (r >> 12) : ((r - NL) >> 8); }
DI int row_key(int r) { return r < NL ? (r & 4095) : (SEQ + ((r - NL) & 255)); }
DI int mod_row(int r) { return r < NL ? (r >> 12) : 8; }

using pg8::Unit;
struct EpiStore {
    bf16_t* O; int ldc;
    DI void operator()(const f32x4 (&acc)[2][2][4][2], const Unit& u, int wr, int wc, int fr, int fq) const {
        asm volatile("" : "+v"(fr), "+v"(fq)); asm volatile("" : "+s"(wr), "+s"(wc));
#pragma unroll
        for (int ai = 0; ai < 2; ++ai)
#pragma unroll
            for (int m = 0; m < 4; ++m) { const int row = u.pm * 256 + ai * 128 + wr * 64 + m * 16 + fr; bf16_t* rp = O + (size_t)row * ldc + u.pn * 256 + wc * 32 + 8 * fq;
#pragma unroll
                for (int bj = 0; bj < 2; ++bj) { const f32x4 v0 = acc[ai][bj][m][0], v1 = acc[ai][bj][m][1]; u32x4 w;
                    w.x = cvtpk(v0[0], v0[1]); w.y = cvtpk(v0[2], v0[3]); w.z = cvtpk(v1[0], v1[1]); w.w = cvtpk(v1[2], v1[3]); *(u32x4*)(rp + bj * 128) = w; } }
    }
};
struct EpiMoe1 {
    bf16_t* O;
    DI void operator()(const f32x4 (&acc)[2][2][4][2], const Unit& u, int wr, int wc, int fr, int fq) const {
        asm volatile("" : "+v"(fr), "+v"(fq)); asm volatile("" : "+s"(wr), "+s"(wc));
#pragma unroll
        for (int ai = 0; ai < 2; ++ai)
#pragma unroll
            for (int m = 0; m < 4; ++m) { const int row = u.pm * 256 + ai * 128 + wr * 64 + m * 16 + fr; bf16_t* rp = O + (size_t)row * 1024 + u.pn * 128 + wc * 32 + 8 * fq;
                float o[8];
#pragma unroll
                for (int n = 0; n < 2; ++n)
#pragma unroll
                    for (int r = 0; r < 4; ++r) { const float a = acc[ai][0][m][n][r], b = acc[ai][1][m][n][r]; o[4 * n + r] = a * sigmoidf_(a) * b; }
                u32x4 w; w.x = cvtpk(o[0], o[1]); w.y = cvtpk(o[2], o[3]); w.z = cvtpk(o[4], o[5]); w.w = cvtpk(o[6], o[7]); *(u32x4*)rp = w; }
    }
};
struct EpiG1 {
    unsigned char* ws; const float* bml; const float* rope;
    DI void st8(bf16_t* p, const f32x4& v0, const f32x4& v1, float s) const { u32x4 w; w.x = cvtpk(v0[0] * s, v0[1] * s); w.y = cvtpk(v0[2] * s, v0[3] * s); w.z = cvtpk(v1[0] * s, v1[1] * s); w.w = cvtpk(v1[2] * s, v1[3] * s); *(u32x4*)p = w; }
    DI void operator()(const f32x4 (&acc)[2][2][4][2], const Unit& u, int wr, int wc, int fr, int fq) const {
        asm volatile("" : "+v"(fr), "+v"(fq)); asm volatile("" : "+s"(wr), "+s"(wc));
        const int pn = u.pn;
#pragma unroll
        for (int ai = 0; ai < 2; ++ai)
#pragma unroll
            for (int m = 0; m < 4; ++m) {
                const int row = u.pm * 256 + ai * 128 + wr * 64 + m * 16 + fr;
#pragma unroll
                for (int bj = 0; bj < 2; ++bj) {
                    const int cl = bj * 128 + wc * 32 + 8 * fq;
                    const f32x4 v0 = acc[ai][bj][m][0], v1 = acc[ai][bj][m][1];
                    if (pn == 0) { st8((bf16_t*)(ws + WS_CQKV) + (size_t)row * 384 + cl, v0, v1, 1.f); }
                    else if (pn == 1) {
                        if (cl < 128) { st8((bf16_t*)(ws + WS_CQKV) + (size_t)row * 384 + 256 + cl, v0, v1, 1.f); }
                        else if (cl < 160) {
                            float o[8] = {v0[0], v0[1], v0[2], v0[3], v1[0], v1[1], v1[2], v1[3]};
                            if (row < NL) { const int n = row & 4095;
#pragma unroll
                                for (int q = 0; q < 4; ++q) { const int pi = ((cl - 128) >> 1) + q, ax = pi >> 3, f = pi & 7, pos = ax ? (n & 63) : (n >> 6);
                                    const f32x2 cs = *(const f32x2*)(rope + (pos * 8 + f) * 2); const float x1 = o[2 * q], x2 = o[2 * q + 1];
                                    o[2 * q] = x1 * cs.x - x2 * cs.y; o[2 * q + 1] = x1 * cs.y + x2 * cs.x; } }
                            u32x4 w; w.x = cvtpk(o[0], o[1]); w.y = cvtpk(o[2], o[3]); w.z = cvtpk(o[4], o[5]); w.w = cvtpk(o[6], o[7]);
                            bf16_t* kp = (bf16_t*)(ws + WS_KBUF) + (size_t)row * 384 + 64 + (cl - 128);
#pragma unroll
                            for (int hd = 0; hd < 4; ++hd) *(u32x4*)(kp + hd * 96) = w;
                        } else if (cl < 176) {
                            float* gp = (float*)(ws + WS_GATES) + (size_t)row * 16 + (cl - 160); const float* bp = bml + (cl - 160);
                            *(f32x4*)gp = v0 + *(const f32x4*)bp; *(f32x4*)(gp + 4) = v1 + *(const f32x4*)(bp + 4);
                        }
                    }
                    else if (pn == 2) { st8((bf16_t*)(ws + WS_NQ) + (size_t)row * 256 + cl, v0, v1, 0.125f * LOG2E); }
                    else if (pn == 3) { st8((bf16_t*)(ws + WS_NK) + (size_t)row * 256 + cl, v0, v1, 1.f); }
                    else if (pn == 4 || pn == 6 || pn == 7 || pn == 8) {
                        const int b = row_batch(row), key = row_key(row);
                        const float o[8] = {v0[0], v0[1], v0[2], v0[3], v1[0], v1[1], v1[2], v1[3]};
                        if (pn == 4) { bf16_t* base = (bf16_t*)(ws + WS_NVT) + (size_t)b * 256 * KEYS + key;
#pragma unroll
                            for (int i = 0; i < 8; ++i) base[(size_t)(cl + i) * KEYS] = f2bf(o[i]); }
                        else if (pn == 6) { bf16_t* base = (bf16_t*)(ws + WS_MKT) + (size_t)b * 256 * KEYS + key;
#pragma unroll
                            for (int i = 0; i < 8; ++i) base[(size_t)(cl + i) * KEYS] = f2bf(o[i] * 0.125f);
                            st8((bf16_t*)(ws + WS_MK) + (size_t)row * 256 + cl, v0, v1, 0.125f); }
                        else { bf16_t* base = (bf16_t*)(ws + WS_MVT) + (size_t)b * 512 * KEYS + key; const int c0 = (pn - 7) * 256 + cl;
#pragma unroll
                            for (int i = 0; i < 8; ++i) base[(size_t)(c0 + i) * KEYS] = f2bf(o[i]); }
                    }
                    else if (pn == 5) { st8((bf16_t*)(ws + WS_MQ) + (size_t)row * 256 + cl, v0, v1, 1.f); }
                    else if (pn < 11) { st8((bf16_t*)(ws + WS_MO) + (size_t)row * 512 + (pn - 9) * 256 + cl, v0, v1, 1.f); }
                    else { st8((bf16_t*)(ws + WS_BG) + (size_t)row * 3072 + (pn - 11) * 256 + cl, v0, v1, 1.f); }
                }
                asm volatile("" ::: "memory");
            }
    }
};
struct EpiG2 {
    unsigned char* ws; const float* rope;
    DI void operator()(const f32x4 (&acc)[2][2][4][2], const Unit& u, int wr, int wc, int fr, int fq) const {
        asm volatile("" : "+v"(fr), "+v"(fq)); asm volatile("" : "+s"(wr), "+s"(wc));
        const int pn = u.pn; const bool isq = pn < 2;
        const bf16_t* A = (const bf16_t*)(ws + WS_CQKV);
#pragma unroll
        for (int ai = 0; ai < 2; ++ai)
#pragma unroll
            for (int m = 0; m < 4; ++m) {
                const int row = u.pm * 256 + ai * 128 + wr * 64 + m * 16 + fr;
                float ss = 0.f; const bf16_t* ap = A + (size_t)row * 384 + (isq ? fq * 64 : 256 + fq * 32); const int nch = isq ? 8 : 4;
                for (int c = 0; c < nch; ++c) { const u32x4 w = *(const u32x4*)(ap + c * 8);
                    float a;
                    a = bflo(w.x); ss += a * a; a = bfhi(w.x); ss += a * a; a = bflo(w.y); ss += a * a; a = bfhi(w.y); ss += a * a;
                    a = bflo(w.z); ss += a * a; a = bfhi(w.z); ss += a * a; a = bflo(w.w); ss += a * a; a = bfhi(w.w); ss += a * a; }
                { const int ln_ = fq * 16 + fr; ss += shx(ss, 16, ln_); ss += shx(ss, 32, ln_); }
                const float rs = rsqrtf(ss * (isq ? (1.f / 256.f) : (1.f / 128.f)) + EPS);
#pragma unroll
                for (int bj = 0; bj < 2; ++bj) {
                    const int c = (pn & 1) * 256 + bj * 128 + wc * 32 + 8 * fq;
                    const f32x4 v0 = acc[ai][bj][m][0], v1 = acc[ai][bj][m][1];
                    float o[8] = {v0[0], v0[1], v0[2], v0[3], v1[0], v1[1], v1[2], v1[3]};
                    if (isq) {
                        if (c < 384) { const int hd = c / 96, e = c - hd * 96; const float s = rs * (0.10206207261596575f * LOG2E);
#pragma unroll
                            for (int i = 0; i < 8; ++i) o[i] *= s;
                            if (e >= 64 && row < NL) { const int n = row & 4095;
#pragma unroll
                                for (int q = 0; q < 4; ++q) { const int pi = ((e - 64) >> 1) + q, ax = pi >> 3, f = pi & 7, pos = ax ? (n & 63) : (n >> 6);
                                    const f32x2 cs = *(const f32x2*)(rope + (pos * 8 + f) * 2); const float x1 = o[2 * q], x2 = o[2 * q + 1];
                                    o[2 * q] = x1 * cs.x - x2 * cs.y; o[2 * q + 1] = x1 * cs.y + x2 * cs.x; } }
                            u32x4 w; w.x = cvtpk(o[0], o[1]); w.y = cvtpk(o[2], o[3]); w.z = cvtpk(o[4], o[5]); w.w = cvtpk(o[6], o[7]);
                            *(u32x4*)((bf16_t*)(ws + WS_Q) + (size_t)row * 384 + c) = w; }
                    } else {
                        const int hd = c >> 7, j = c & 127;
#pragma unroll
                        for (int i = 0; i < 8; ++i) o[i] *= rs;
                        if (j < 64) { u32x4 w; w.x = cvtpk(o[0], o[1]); w.y = cvtpk(o[2], o[3]); w.z = cvtpk(o[4], o[5]); w.w = cvtpk(o[6], o[7]);
                            *(u32x4*)((bf16_t*)(ws + WS_KBUF) + (size_t)row * 384 + hd * 96 + j) = w; }
                        else { const int b = row_batch(row), key = row_key(row);
                            bf16_t* base = (bf16_t*)(ws + WS_VT) + ((size_t)(b * 4 + hd) * 64 + (j - 64)) * KEYS + key;
#pragma unroll
                            for (int i = 0; i < 8; ++i) base[(size_t)i * KEYS] = f2bf(o[i]); }
                    }
                }
                asm volatile("" ::: "memory");
            }
    }
};

DI void tr_item(const float* W, int ldw, int c0, int k0, bf16_t* dst, int ldd, int dk0, const float* ksc, bool perm, bool zero, LAS float* scr, int lane) {
    if (!zero) {
#pragma unroll 8
        for (int i = 0; i < 32; ++i) { const int kk = 2 * i + (lane >> 5); float v = W[(size_t)(k0 + kk) * ldw + c0 + (lane & 31)]; if (ksc) v *= ksc[k0 + kk]; scr[kk * 33 + (lane & 31)] = v; }
    }
    asm volatile("s_waitcnt lgkmcnt(0)" ::: "memory");
    const int c = lane & 7;
#pragma unroll
    for (int j = 0; j < 4; ++j) { const int n = (lane >> 3) + 8 * j; const LAS float* s = scr + (8 * c) * 33 + n;
        u32x4 o = {0u, 0u, 0u, 0u};
        if (!zero) { o.x = cvtpk(s[0 * 33], s[1 * 33]); o.y = cvtpk(s[2 * 33], s[3 * 33]); o.z = cvtpk(s[4 * 33], s[5 * 33]); o.w = cvtpk(s[6 * 33], s[7 * 33]); }
        const int rown = perm ? (2 * ((n >> 4) * 8 + (n & 7)) + ((n >> 3) & 1)) : n;
        *(u32x4*)(dst + (size_t)rown * ldd + dk0 + 8 * c) = o; }
    asm volatile("s_waitcnt lgkmcnt(0)" ::: "memory");
}
DI void conv_small_item(const Ctx& c, int l, int it, LAS float* scr) {
    unsigned char* sw = c.ws + WS_SW + (size_t)l * SW_STRIDE;
    if (it < 184 * 16) {
        const int rb = it >> 4, kb = it & 15, r0 = rb * 32; const float* W = c.in[I_WIN] + (size_t)l * 1024 * DIN;
        int src; bool zero = false, perm = false;
        if (r0 < 416) { src = r0; perm = (r0 == 384); } else if (r0 < 448) src = 2720 + (r0 - 416); else if (r0 < 512) { src = 0; zero = true; } else if (r0 < 2816) src = r0 - 96; else src = r0 - 80;
        tr_item(W, DIN, src, kb * 64, (bf16_t*)(sw + SW_WIN) + (size_t)r0 * 1024, 1024, kb * 64, nullptr, perm, zero, scr, c.lane); return; }
    it -= 184 * 16;
    if (it < 192) {
        const int rb = it / 6, kb = it % 6; bf16_t* dst = (bf16_t*)(sw + SW_WQKV) + (size_t)rb * 32 * 384;
        if (rb < 12) { const int hd = rb / 3, part = rb % 3;
            tr_item(c.in[I_WUQ] + (size_t)l * 256 * 384, 384, hd * 96 + part * 32, (kb & 3) * 64, dst, 384, kb * 64, c.in[I_GQ] + l * 256, part == 2, kb >= 4, scr, c.lane); }
        else if (rb < 16) tr_item(nullptr, 0, 0, 0, dst, 384, kb * 64, nullptr, false, true, scr, c.lane);
        else tr_item(c.in[I_WUKV] + (size_t)l * 128 * 512, 512, (rb - 16) * 32, (kb & 1) * 64, dst, 384, kb * 64, c.in[I_GKV] + l * 128, false, kb < 4, scr, c.lane);
        return; }
    it -= 192;
    if (it < 128) { tr_item(c.in[I_WBRA] + (size_t)l * 256 * 1024, 1024, (it >> 2) * 32, (it & 3) * 64, (bf16_t*)(sw + SW_WA) + (size_t)(it >> 2) * 32 * 256, 256, (it & 3) * 64, nullptr, false, false, scr, c.lane); return; }
    it -= 128;
    if (it < 128) { tr_item(c.in[I_WBRB] + (size_t)l * 256 * 1024, 1024, (it >> 2) * 32, (it & 3) * 64, (bf16_t*)(sw + SW_WB) + (size_t)(it >> 2) * 32 * 256, 256, (it & 3) * 64, nullptr, false, false, scr, c.lane); return; }
    it -= 128;
    if (it < 256) { tr_item(c.in[I_WBRM] + (size_t)l * 512 * 1024, 1024, (it >> 3) * 32, (it & 7) * 64, (bf16_t*)(sw + SW_WM) + (size_t)(it >> 3) * 32 * 512, 512, (it & 7) * 64, nullptr, false, false, scr, c.lane); return; }
    it -= 256;
    tr_item(c.in[I_WOUT] + (size_t)l * 1024 * 1024, 1024, (it >> 4) * 32, (it & 15) * 64, (bf16_t*)(sw + SW_WOUT) + (size_t)(it >> 4) * 32 * 1024, 1024, (it & 15) * 64, nullptr, false, false, scr, c.lane);
}
constexpr int SMALL_ITEMS = 184 * 16 + 192 + 128 + 128 + 256 + 512;
DI void conv_moe_item(const Ctx& c, int l, int it, LAS float* scr) {
    if (it < 16 * 2 * 32 * 16) { const int kb = it & 15, nb = (it >> 4) & 31, src = (it >> 9) & 1, e = it >> 10;
        const float* W = c.in[src ? I_WE3 : I_WE1] + ((size_t)l * 16 + e) * 1024 * 1024; const int c0 = nb * 32, r0 = 256 * (c0 >> 7) + (c0 & 127) + 128 * src;
        tr_item(W, 1024, c0, kb * 64, wsp<bf16_t>(c, WS_W13) + ((size_t)e * 2048 + r0) * 1024, 1024, kb * 64, nullptr, false, false, scr, c.lane); return; }
    it -= 16 * 2 * 32 * 16;
    { const int kb = it & 15, nb = (it >> 4) & 31, e = it >> 9;
        const float* W = c.in[I_WE2] + ((size_t)l * 16 + e) * 1024 * 1024;
        tr_item(W, 1024, nb * 32, kb * 64, wsp<bf16_t>(c, WS_W2) + ((size_t)e * 1024 + nb * 32) * 1024, 1024, kb * 64, nullptr, false, false, scr, c.lane); }
}
constexpr int MOE_ITEMS = 16 * 2 * 32 * 16 + 16 * 32 * 16;

DI void phase_A(const Ctx& c) {
    LAS float* st = (LAS float*)c.lds;
    LAS float* red = (LAS float*)(c.lds + 36864);
    for (int item = c.vcu; item < 96; item += c.G) {
        for (int i = c.tid; i < 9 * 1024; i += 512) { const int r = i >> 10, k = i & 1023; const float v = r < 8 ? c.in[I_C][r * 1024 + k] : c.in[I_CCTX][k]; st[i] = v / (1.f + __expf(-v)); }
        __syncthreads();
        const int l = item / 48, cb = (item % 48) * 128, slice = c.wave * 2 + (c.lane >> 5), ks = slice * 64, cl = (c.lane & 31) * 4;
        f32x4 a[9];
#pragma unroll
        for (int r = 0; r < 9; ++r) a[r] = (f32x4){0.f, 0.f, 0.f, 0.f};
        const float* W = c.in[I_WMOD] + ((size_t)l * 1024 + ks) * 6144 + cb + cl;
#pragma unroll 4
        for (int kk = 0; kk < 64; ++kk) { const f32x4 w = *(const f32x4*)(W + (size_t)kk * 6144);
#pragma unroll
            for (int r = 0; r < 9; ++r) a[r] += w * st[r * 1024 + ks + kk]; }
#pragma unroll
        for (int r = 0; r < 9; ++r) *(LAS f32x4*)(red + (slice * 9 + r) * 128 + cl) = a[r];
        __syncthreads();
        for (int o = c.tid; o < 9 * 128; o += 512) { const int r = o >> 7, ci = o & 127; float s = 0.f;
#pragma unroll
            for (int sl = 0; sl < 16; ++sl) s += red[(sl * 9 + r) * 128 + ci];
            wsp<float>(c, WS_MOD)[((size_t)l * 9 + r) * 6144 + cb + ci] = s + c.in[I_BMOD][l * 6144 + cb + ci]; }
        __syncthreads();
    }
    if (c.vcu == c.G - 1) for (int i = c.tid; i < 512; i += 512) { const int pos = i >> 3, f = i & 7;
        const float inv = exp2f(-(float)f * (13.287712379549449f / 8.f)); const float ang = (float)pos * inv; float rev = ang * 0.15915494309189535f; rev -= floorf(rev);
        wsp<float>(c, WS_ROPE)[2 * i] = __builtin_amdgcn_cosf(rev); wsp<float>(c, WS_ROPE)[2 * i + 1] = __builtin_amdgcn_sinf(rev); }
    LAS float* scr = (LAS float*)(c.lds + c.wave * 16384);
    __syncthreads();
    const int gw = c.vcu * 8 + c.wave, NGW = c.G * 8;
    for (int it = gw; it < 2 * SMALL_ITEMS; it += NGW) conv_small_item(c, it / SMALL_ITEMS, it % SMALL_ITEMS, scr);
}

DI void prenorm_store(const f32x4 (&x)[4], const float* g, const float* sh, const float* sc, bf16_t* orow, int lane) {
    float ss = 0.f;
#pragma unroll
    for (int j = 0; j < 4; ++j) ss += (x[j].x * x[j].x + x[j].y * x[j].y) + (x[j].z * x[j].z + x[j].w * x[j].w);
    const float rs = rsqrtf(wave_sum(ss, lane) * (1.f / 1024.f) + EPS);
#pragma unroll
    for (int j = 0; j < 4; ++j) { const int col = 4 * lane + 256 * j; const f32x4 gg = *(const f32x4*)(g + col), s1 = *(const f32x4*)(sc + col), s0 = *(const f32x4*)(sh + col);
        const f32x4 h = x[j] * rs * gg * (s1 + 1.f) + s0; u32x2 w; w.x = cvtpk(h.x, h.y); w.y = cvtpk(h.z, h.w); *(u32x2*)(orow + col) = w; }
}
DI void phase_B(const Ctx& c) {
    const int gw = c.vcu * 8 + c.wave, NGW = c.G * 8;
    for (int r = gw; r < NT; r += NGW) {
        const float* xr = r < NL ? c.in[I_X] + (size_t)r * 1024 : c.in[I_CTX] + (size_t)(r - NL) * 1024;
        f32x4 x[4];
#pragma unroll
        for (int j = 0; j < 4; ++j) x[j] = *(const f32x4*)(xr + 4 * c.lane + 256 * j);
        const float* mod = wsp<float>(c, WS_MOD) + (size_t)mod_row(r) * 6144;
        prenorm_store(x, c.in[I_GPRE1], mod, mod + 1024, wsp<bf16_t>(c, WS_HBUF) + (size_t)r * 1024, c.lane);
    }
}
DI void phase_rows1(const Ctx& c, int l) {
    const int gw = c.vcu * 8 + c.wave, NGW = c.G * 8, nrows = (l == 0) ? NT : NL;
    const float* gpost = c.in[I_GPOST1] + l * 1024; const float* gpre2 = c.in[I_GPRE2] + l * 1024; const float* wr = c.in[I_WR] + (size_t)l * 1024 * 16;
    for (int r = gw; r < nrows; r += NGW) {
        const float* xr; float* xw;
        if (r < NL) { xr = (l == 0) ? c.in[I_X] + (size_t)r * 1024 : c.out + (size_t)r * 1024; xw = c.out + (size_t)r * 1024; }
        else { xr = c.in[I_CTX] + (size_t)(r - NL) * 1024; xw = wsp<float>(c, WS_XC) + (size_t)(r - NL) * 1024; }
        const float* mod = wsp<float>(c, WS_MOD) + ((size_t)l * 9 + mod_row(r)) * 6144;
        const bf16_t* yo = wsp<bf16_t>(c, WS_YO) + (size_t)r * 1024;
        f32x4 x[4], y[4]; float ss = 0.f;
#pragma unroll
        for (int j = 0; j < 4; ++j) { const int col = 4 * c.lane + 256 * j; x[j] = *(const f32x4*)(xr + col); const u32x2 w = *(const u32x2*)(yo + col);
            y[j] = (f32x4){bflo(w.x), bfhi(w.x), bflo(w.y), bfhi(w.y)}; ss += (y[j].x * y[j].x + y[j].y * y[j].y) + (y[j].z * y[j].z + y[j].w * y[j].w); }
        const float rs = rsqrtf(wave_sum(ss, c.lane) * (1.f / 1024.f) + EPS);
        float ss2 = 0.f;
#pragma unroll
        for (int j = 0; j < 4; ++j) { const int col = 4 * c.lane + 256 * j; const f32x4 gt = *(const f32x4*)(mod + 2048 + col), gp = *(const f32x4*)(gpost + col);
            x[j] = x[j] + gt * (y[j] * rs * gp); *(f32x4*)(xw + col) = x[j]; ss2 += (x[j].x * x[j].x + x[j].y * x[j].y) + (x[j].z * x[j].z + x[j].w * x[j].w); }
        const float rs2 = rsqrtf(wave_sum(ss2, c.lane) * (1.f / 1024.f) + EPS);
        float lg[16];
#pragma unroll
        for (int e = 0; e < 16; ++e) lg[e] = 0.f;
        bf16_t* h2 = wsp<bf16_t>(c, WS_HBUF) + (size_t)r * 1024;
#pragma unroll
        for (int j = 0; j < 4; ++j) { const int col = 4 * c.lane + 256 * j; const f32x4 gg = *(const f32x4*)(gpre2 + col), s1 = *(const f32x4*)(mod + 4096 + col), s0 = *(const f32x4*)(mod + 3072 + col);
            const f32x4 h = x[j] * rs2 * gg * (s1 + 1.f) + s0; u32x2 w; w.x = cvtpk(h.x, h.y); w.y = cvtpk(h.z, h.w); *(u32x2*)(h2 + col) = w;
#pragma unroll
            for (int q = 0; q < 4; ++q) { const float* wp = wr + (size_t)(col + q) * 16; const float hv = h[q];
#pragma unroll
                for (int e4 = 0; e4 < 4; ++e4) { const f32x4 w4 = *(const f32x4*)(wp + 4 * e4); lg[4 * e4] += hv * w4.x; lg[4 * e4 + 1] += hv * w4.y; lg[4 * e4 + 2] += hv * w4.z; lg[4 * e4 + 3] += hv * w4.w; } } }
#pragma unroll
        for (int e = 0; e < 16; ++e) lg[e] = wave_sum(lg[e], c.lane);
        float mx = lg[0];
#pragma unroll
        for (int e = 1; e < 16; ++e) mx = fmaxf(mx, lg[e]);
        float den = 0.f;
#pragma unroll
        for (int e = 0; e < 16; ++e) { lg[e] = __expf(lg[e] - mx); den += lg[e]; }
        float mine = 0.f;
#pragma unroll
        for (int e = 0; e < 16; ++e) mine = (c.lane == e) ? lg[e] : mine;
        if (c.lane < 16) { const float a = mine / den;
            if (r < NL) wsp<float>(c, WS_AFF)[((size_t)(r >> 12) * 16 + c.lane) * 4096 + (r & 4095)] = a;
            else { const int j = r - NL; wsp<float>(c, WS_AFFC)[((size_t)(j >> 8) * 16 + c.lane) * 256 + (j & 255)] = a; } }
    }
}
DI void topk_unit(const Ctx& c, const float* aff, int N, int cap, int* idx_out, short* inv_base  , int e) {
    LAS unsigned* red = (LAS unsigned*)c.lds;
    unsigned key[8]; bool valid[8];
#pragma unroll
    for (int j = 0; j < 8; ++j) { const int i = c.tid * 8 + j; valid[j] = i < N; key[j] = valid[j] ? __float_as_uint(aff[i]) : 0u; }
    unsigned prefix = 0u;
    for (int bit = 30; bit >= 0; --bit) {
        const unsigned cand = prefix | (1u << bit); unsigned cnt = 0u;
#pragma unroll
        for (int j = 0; j < 8; ++j) cnt += (valid[j] && key[j] >= cand) ? 1u : 0u;
#pragma unroll
        for (int o = 1; o < 64; o <<= 1) cnt += shxu(cnt, o, c.lane);
        LAS unsigned* rb = red + (bit & 1) * 8;
        if (c.lane == 0) rb[c.wave] = cnt;
        __syncthreads();
        unsigned tot = 0u;
#pragma unroll
        for (int w = 0; w < 8; ++w) tot += rb[w];
        if (tot >= (unsigned)cap) prefix = cand;
    }
    const unsigned T = prefix;
    unsigned ngt = 0u, neq = 0u;
#pragma unroll
    for (int j = 0; j < 8; ++j) { ngt += (valid[j] && key[j] > T) ? 1u : 0u; neq += (valid[j] && key[j] == T) ? 1u : 0u; }
    unsigned comb = ngt | (neq << 16), inc = comb;
#pragma unroll
    for (int o = 1; o < 64; o <<= 1) { const unsigned t = shupu(inc, o, c.lane); if (c.lane >= o) inc += t; }
    __syncthreads();
    LAS unsigned* sc = red + 16;
    if (c.lane == 63) sc[c.wave] = inc;
    __syncthreads();
    unsigned woff = 0u, total = 0u;
#pragma unroll
    for (int w = 0; w < 8; ++w) { const unsigned v = sc[w]; if (w < c.wave) woff += v; total += v; }
    const unsigned excl = woff + inc - comb; unsigned gr = excl & 0xffffu, er = excl >> 16; const unsigned tgt = total & 0xffffu, need = (unsigned)cap - tgt;
#pragma unroll
    for (int j = 0; j < 8; ++j) { const int i = c.tid * 8 + j; if (!valid[j]) continue; int slot = -1;
        if (key[j] > T) { slot = (int)gr; ++gr; } else if (key[j] == T) { if (er < need) slot = (int)(tgt + er); ++er; }
        if (slot >= 0) idx_out[slot] = i;
        inv_base[(size_t)i * 16 + e] = (short)slot; }
    __syncthreads();
}
DI void phase_topk(const Ctx& c, int l) {
    const int nunits = (l == 0) ? 256 : 128;
    for (int u = c.vcu; u < nunits; u += c.G) {
        if (u < 128) { const int b = u >> 4, e = u & 15; topk_unit(c, wsp<float>(c, WS_AFF) + (size_t)u * 4096, 4096, 512, wsp<int>(c, WS_IDX) + (size_t)u * 512, wsp<short>(c, WS_INV) + (size_t)b * 4096 * 16, e); }
        else { const int v = u - 128, b = v >> 4, e = v & 15; topk_unit(c, wsp<float>(c, WS_AFFC) + (size_t)v * 256, 256, 32, wsp<int>(c, WS_IDXC) + (size_t)v * 32, wsp<short>(c, WS_INVC) + (size_t)b * 256 * 16, e); }
    }
    LAS float* scr = (LAS float*)(c.lds + 1024 + c.wave * 16384);
    const int gw = (c.G - 1 - c.vcu) * 8 + c.wave, NGW = c.G * 8;
    for (int it = gw; it < MOE_ITEMS; it += NGW) conv_moe_item(c, l, it, scr);
}
DI void phase_gather(const Ctx& c, int l) {
    const int gw = c.vcu * 8 + c.wave, NGW = c.G * 8, nrows = (l == 0) ? 69632 : 65536;
    for (int r = gw; r < nrows; r += NGW) {
        int src;
        if (r < 65536) { const int e = r >> 12, b = (r >> 9) & 7, s = r & 511; src = b * 4096 + wsp<int>(c, WS_IDX)[(b * 16 + e) * 512 + s]; }
        else { const int j = r - 65536, e = j >> 8, b = (j >> 5) & 7, s = j & 31; src = NL + b * 256 + wsp<int>(c, WS_IDXC)[(b * 16 + e) * 32 + s]; }
        const u32x4* sp = (const u32x4*)(wsp<bf16_t>(c, WS_HBUF) + (size_t)src * 1024); u32x4* dp = (u32x4*)(wsp<bf16_t>(c, WS_XS) + (size_t)r * 1024);
        dp[c.lane] = sp[c.lane]; dp[c.lane + 64] = sp[c.lane + 64];
    }
}
DI void phase_rows2(const Ctx& c, int l) {
    const int gw = c.vcu * 8 + c.wave, NGW = c.G * 8, nrows = (l == 0) ? NT : NL;
    const float* gpost = c.in[I_GPOST2] + l * 1024; const bf16_t* YE = wsp<bf16_t>(c, WS_XS);
    for (int r = gw; r < nrows; r += NGW) {
        f32x4 a[4];
#pragma unroll
        for (int j = 0; j < 4; ++j) a[j] = (f32x4){0.f, 0.f, 0.f, 0.f};
        float* xw; const short* inv; int b, n;
        if (r < NL) { b = r >> 12; n = r & 4095; xw = c.out + (size_t)r * 1024; inv = wsp<short>(c, WS_INV) + (size_t)r * 16; }
        else { const int j = r - NL; b = j >> 8; n = j & 255; xw = wsp<float>(c, WS_XC) + (size_t)j * 1024; inv = wsp<short>(c, WS_INVC) + (size_t)j * 16; }
        for (int e = 0; e < 16; ++e) { const int slot = inv[e]; if (slot < 0) continue;
            float g; size_t yr;
            if (r < NL) { g = wsp<float>(c, WS_AFF)[((size_t)b * 16 + e) * 4096 + n]; yr = ((size_t)(e * 8 + b)) * 512 + slot; }
            else { g = wsp<float>(c, WS_AFFC)[((size_t)b * 16 + e) * 256 + n]; yr = 65536 + (size_t)e * 256 + b * 32 + slot; }
            const bf16_t* yp = YE + yr * 1024;
#pragma unroll
            for (int j = 0; j < 4; ++j) { const u32x2 w = *(const u32x2*)(yp + 4 * c.lane + 256 * j); a[j] += (f32x4){bflo(w.x), bfhi(w.x), bflo(w.y), bfhi(w.y)} * g; } }
        float ss = 0.f;
#pragma unroll
        for (int j = 0; j < 4; ++j) ss += (a[j].x * a[j].x + a[j].y * a[j].y) + (a[j].z * a[j].z + a[j].w * a[j].w);
        const float rs = rsqrtf(wave_sum(ss, c.lane) * (1.f / 1024.f) + EPS);
        const float* mod = wsp<float>(c, WS_MOD) + ((size_t)l * 9 + mod_row(r)) * 6144;
        f32x4 x[4];
#pragma unroll
        for (int j = 0; j < 4; ++j) { const int col = 4 * c.lane + 256 * j; const f32x4 gt = *(const f32x4*)(mod + 5120 + col), gp = *(const f32x4*)(gpost + col);
            x[j] = *(const f32x4*)(xw + col) + gt * (a[j] * rs * gp); *(f32x4*)(xw + col) = x[j]; }
        if (l == 0) { const float* mod1 = wsp<float>(c, WS_MOD) + ((size_t)9 + mod_row(r)) * 6144;
            prenorm_store(x, c.in[I_GPRE1] + 1024, mod1, mod1 + 1024, wsp<bf16_t>(c, WS_HBUF) + (size_t)r * 1024, c.lane); }
    }
}
DI void phase_combine(const Ctx& c, int l) {
    const size_t total = (size_t)((l == 0) ? NT : NL) * 128; const size_t stride = (size_t)c.G * 512;
    bf16_t* P = wsp<bf16_t>(c, WS_P); const bf16_t* BG = wsp<bf16_t>(c, WS_BG);
    for (size_t i = (size_t)c.vcu * 512 + c.tid; i < total; i += stride) { const size_t r = i >> 7; const int cg = (int)(i & 127) * 8;
        float y[8];
#pragma unroll
        for (int q = 0; q < 8; ++q) y[q] = 0.f;
#pragma unroll
        for (int br = 0; br < 3; ++br) { const u32x4 g = *(const u32x4*)(BG + r * 3072 + br * 1024 + cg), p = *(const u32x4*)(P + r * 3072 + br * 1024 + cg);
            y[0] += sigmoidf_(bflo(g.x)) * bflo(p.x); y[1] += sigmoidf_(bfhi(g.x)) * bfhi(p.x); y[2] += sigmoidf_(bflo(g.y)) * bflo(p.y); y[3] += sigmoidf_(bfhi(g.y)) * bfhi(p.y);
            y[4] += sigmoidf_(bflo(g.z)) * bflo(p.z); y[5] += sigmoidf_(bfhi(g.z)) * bfhi(p.z); y[6] += sigmoidf_(bflo(g.w)) * bflo(p.w); y[7] += sigmoidf_(bfhi(g.w)) * bfhi(p.w); }
        u32x4 w; w.x = cvtpk(y[0], y[1]); w.y = cvtpk(y[2], y[3]); w.z = cvtpk(y[4], y[5]); w.w = cvtpk(y[6], y[7]); *(u32x4*)(P + r * 3072 + cg) = w; }
}

constexpr int MLA_KP = 208, MLA_VP = 136, MLA_STAGE = 64 * MLA_KP + 64 * MLA_VP;
DI void mla_unit(const Ctx& c, int b, int hd, int qrow0, int kt0, int kt1) {
    const int lane = c.lane, r32 = lane & 31, hh = lane >> 5, w = c.wave, tid = c.tid;
    const bf16_t* Q = wsp<bf16_t>(c, WS_Q); const bf16_t* KB = wsp<bf16_t>(c, WS_KBUF); const bf16_t* VT = wsp<bf16_t>(c, WS_VT) + (size_t)(b * 4 + hd) * 64 * KEYS;
    bf16x8 qf[6];
    { const bf16_t* qp = Q + (size_t)(qrow0 + 32 * w + r32) * 384 + hd * 96 + 8 * hh;
#pragma unroll
        for (int kk = 0; kk < 6; ++kk) qf[kk] = *(const bf16x8*)(qp + 16 * kk); }
    f32x16 o0, o1;
#pragma unroll
    for (int i = 0; i < 16; ++i) { o0[i] = 0.f; o1[i] = 0.f; }
    float mrun = -1e30f, lsum = 0.f;
    const int kc0 = tid, kc1 = tid + 512; const bool has1 = kc1 < 768;
    const int kkey0 = kc0 / 12, kpart0 = kc0 % 12, kkey1 = has1 ? kc1 / 12 : 0, kpart1 = has1 ? kc1 % 12 : 0;
    const int vv = tid >> 3, vpart = tid & 7;
    u32x4 rk0, rk1, rv; rk1 = (u32x4){0u, 0u, 0u, 0u};
    auto krow = [&](int kt) -> size_t { return kt < 64 ? (size_t)b * 4096 + 64 * kt : (size_t)NL + b * 256 + 64 * (kt - 64); };
#define MLA_LOAD(kt) do { const size_t _r = krow(kt); rk0 = *(const u32x4*)(KB + (_r + kkey0) * 384 + hd * 96 + kpart0 * 8); \
        if (has1) rk1 = *(const u32x4*)(KB + (_r + kkey1) * 384 + hd * 96 + kpart1 * 8); rv = *(const u32x4*)(VT + (size_t)vv * KEYS + 64 * (kt) + vpart * 8); } while (0)
#define MLA_WRITE(buf) do { LAS unsigned char* _s = c.lds + (buf) * MLA_STAGE; *(LAS u32x4*)(_s + kkey0 * MLA_KP + kpart0 * 16) = rk0; if (has1) *(LAS u32x4*)(_s + kkey1 * MLA_KP + kpart1 * 16) = rk1; \
        LAS unsigned char* _v = _s + 64 * MLA_KP + vv * MLA_VP + vpart * 16; *(LAS u32x2*)_v = (u32x2){rv.x, rv.y}; *(LAS u32x2*)(_v + 8) = (u32x2){rv.z, rv.w}; } while (0)
    MLA_LOAD(kt0); MLA_WRITE(0); __syncthreads();
    for (int kt = kt0; kt < kt1; ++kt) {
        const int buf = (kt - kt0) & 1;
        if (kt + 1 < kt1) MLA_LOAD(kt + 1);
        const LAS unsigned char* Kl = c.lds + buf * MLA_STAGE; const LAS unsigned char* Vl = Kl + 64 * MLA_KP;
        f32x16 s0, s1;
#pragma unroll
        for (int i = 0; i < 16; ++i) { s0[i] = 0.f; s1[i] = 0.f; }
#pragma unroll
        for (int kk = 0; kk < 6; ++kk) { const bf16x8 k0 = *(const LAS bf16x8*)(Kl + r32 * MLA_KP + (16 * kk + 8 * hh) * 2), k1 = *(const LAS bf16x8*)(Kl + (32 + r32) * MLA_KP + (16 * kk + 8 * hh) * 2);
            s0 = MFMA32(k0, qf[kk], s0); s1 = MFMA32(k1, qf[kk], s1); }
        float mx = s0[0];
#pragma unroll
        for (int i = 1; i < 16; ++i) mx = fmaxf(mx, s0[i]);
#pragma unroll
        for (int i = 0; i < 16; ++i) mx = fmaxf(mx, s1[i]);
        mx = fmaxf(mx, shx(mx, 32, lane));
        const float mnew = fmaxf(mrun, mx), alpha = ex2(mrun - mnew); mrun = mnew;
        float ps = 0.f;
#pragma unroll
        for (int i = 0; i < 16; ++i) { s0[i] = ex2(s0[i] - mnew); s1[i] = ex2(s1[i] - mnew); ps += s0[i] + s1[i]; }
        lsum = lsum * alpha + ps;
#pragma unroll
        for (int i = 0; i < 16; ++i) { o0[i] *= alpha; o1[i] *= alpha; }
        const bf16x8 p00 = pack8(s0[0], s0[1], s0[2], s0[3], s0[4], s0[5], s0[6], s0[7]), p01 = pack8(s0[8], s0[9], s0[10], s0[11], s0[12], s0[13], s0[14], s0[15]);
        const bf16x8 p10 = pack8(s1[0], s1[1], s1[2], s1[3], s1[4], s1[5], s1[6], s1[7]), p11 = pack8(s1[8], s1[9], s1[10], s1[11], s1[12], s1[13], s1[14], s1[15]);
#define MLA_PV(oacc, vt, pf, kofs) do { const LAS unsigned char* _p = Vl + (32 * (vt) + r32) * MLA_VP + ((kofs) + 4 * hh) * 2; const s16x4 lo = *(const LAS s16x4*)_p, hi = *(const LAS s16x4*)(_p + 16); \
        oacc = MFMA32(__builtin_shufflevector(lo, hi, 0, 1, 2, 3, 4, 5, 6, 7), pf, oacc); } while (0)
        MLA_PV(o0, 0, p00, 0); MLA_PV(o0, 0, p01, 16); MLA_PV(o0, 0, p10, 32); MLA_PV(o0, 0, p11, 48);
        MLA_PV(o1, 1, p00, 0); MLA_PV(o1, 1, p01, 16); MLA_PV(o1, 1, p10, 32); MLA_PV(o1, 1, p11, 48);
        if (kt + 1 < kt1) MLA_WRITE(buf ^ 1);
        __syncthreads();
    }
    lsum += shx(lsum, 32, lane);
    const float inv = 1.f / lsum;
    bf16_t* op = wsp<bf16_t>(c, WS_CQKV) + (size_t)(qrow0 + 32 * w + r32) * 256 + hd * 64 + 4 * hh;
#pragma unroll
    for (int g = 0; g < 4; ++g) { u32x2 w0, w1; w0.x = cvtpk(o0[4 * g] * inv, o0[4 * g + 1] * inv); w0.y = cvtpk(o0[4 * g + 2] * inv, o0[4 * g + 3] * inv);
        w1.x = cvtpk(o1[4 * g] * inv, o1[4 * g + 1] * inv); w1.y = cvtpk(o1[4 * g + 2] * inv, o1[4 * g + 3] * inv);
        *(u32x2*)(op + 8 * g) = w0; *(u32x2*)(op + 32 + 8 * g) = w1; }
#undef MLA_LOAD
#undef MLA_WRITE
#undef MLA_PV
}

DI void na_unit(const Ctx& c, const float* rpb_l, int b, int hd, int r0  ) {
    const int lane = c.lane, r32 = lane & 31, hh = lane >> 5, w = c.wave;
    LAS float* bias = (LAS float*)c.lds;
    for (int i = c.tid; i < 465; i += 512) bias[i] = rpb_l[hd * 465 + i] * LOG2E;
    __syncthreads();
    const bool isctx = r0 < 0;
    const int gr = isctx ? 0 : r0 + (w >> 1), half = w & 1, wq = 32 * half + r32;
    const int qrow = isctx ? NL + b * 256 + 32 * w + r32 : b * 4096 + gr * 64 + wq;
    bf16_t* NQ = wsp<bf16_t>(c, WS_NQ); const bf16_t* NK = wsp<bf16_t>(c, WS_NK); const bf16_t* NVT = wsp<bf16_t>(c, WS_NVT) + (size_t)(b * 4 + hd) * 64 * KEYS;
    bf16x8 qf[4];
#pragma unroll
    for (int kk = 0; kk < 4; ++kk) qf[kk] = *(const bf16x8*)(NQ + (size_t)qrow * 256 + hd * 64 + 16 * kk + 8 * hh);
    f32x16 o0, o1;
#pragma unroll
    for (int i = 0; i < 16; ++i) { o0[i] = 0.f; o1[i] = 0.f; }
    float mrun = -1e30f, lsum = 0.f;
    const int rs = isctx ? 0 : min(max(gr - 4, 0), 56), cs = min(max(wq - 8, 0), 48);
    const int ntiles = isctx ? 8 : 24;
    for (int t = 0; t < ntiles; ++t) {
        int keyrow0, keyidx0, dr = 0, colb = 0; const bool local = t >= 8;
        if (!local) { keyrow0 = NL + b * 256 + 32 * t; keyidx0 = SEQ + 32 * t; }
        else { const int rr = (t - 8) >> 1, ch = (t - 8) & 1; keyidx0 = (rs + rr) * 64 + 32 * ch; keyrow0 = b * 4096 + keyidx0; dr = rs + rr - gr; colb = 32 * ch; }
        f32x16 s;
#pragma unroll
        for (int i = 0; i < 16; ++i) s[i] = 0.f;
        const bf16_t* kp = NK + (size_t)(keyrow0 + r32) * 256 + hd * 64 + 8 * hh;
#pragma unroll
        for (int kk = 0; kk < 4; ++kk) s = MFMA32(*(const bf16x8*)(kp + 16 * kk), qf[kk], s);
        if (local) {
#pragma unroll
            for (int i = 0; i < 16; ++i) { const int kc = colb + crow(i, hh); const bool ok = kc >= cs && kc < cs + 16; const int bi = (dr + 7) * 31 + (kc - wq + 15);
                s[i] = ok ? s[i] + bias[ok ? bi : 0] : -INFINITY; } }
        float mx = s[0];
#pragma unroll
        for (int i = 1; i < 16; ++i) mx = fmaxf(mx, s[i]);
        mx = fmaxf(mx, shx(mx, 32, lane));
        const float mnew = fmaxf(mrun, mx), alpha = ex2(mrun - mnew); mrun = mnew;
        float ps = 0.f;
#pragma unroll
        for (int i = 0; i < 16; ++i) { s[i] = ex2(s[i] - mnew); ps += s[i]; }
        lsum = lsum * alpha + ps;
#pragma unroll
        for (int i = 0; i < 16; ++i) { o0[i] *= alpha; o1[i] *= alpha; }
        const bf16x8 p0 = pack8(s[0], s[1], s[2], s[3], s[4], s[5], s[6], s[7]), p1 = pack8(s[8], s[9], s[10], s[11], s[12], s[13], s[14], s[15]);
        const bf16_t* vp0 = NVT + (size_t)r32 * KEYS + keyidx0 + 4 * hh; const bf16_t* vp1 = vp0 + (size_t)32 * KEYS;
        { const s16x4 lo = *(const s16x4*)vp0, hi = *(const s16x4*)(vp0 + 8); o0 = MFMA32(__builtin_shufflevector(lo, hi, 0, 1, 2, 3, 4, 5, 6, 7), p0, o0); }
        { const s16x4 lo = *(const s16x4*)(vp0 + 16), hi = *(const s16x4*)(vp0 + 24); o0 = MFMA32(__builtin_shufflevector(lo, hi, 0, 1, 2, 3, 4, 5, 6, 7), p1, o0); }
        { const s16x4 lo = *(const s16x4*)vp1, hi = *(const s16x4*)(vp1 + 8); o1 = MFMA32(__builtin_shufflevector(lo, hi, 0, 1, 2, 3, 4, 5, 6, 7), p0, o1); }
        { const s16x4 lo = *(const s16x4*)(vp1 + 16), hi = *(const s16x4*)(vp1 + 24); o1 = MFMA32(__builtin_shufflevector(lo, hi, 0, 1, 2, 3, 4, 5, 6, 7), p1, o1); }
    }
    lsum += shx(lsum, 32, lane);
    const float inv = 1.f / lsum;
    bf16_t* op = NQ + (size_t)qrow * 256 + hd * 64 + 4 * hh;
#pragma unroll
    for (int g = 0; g < 4; ++g) { u32x2 w0, w1; w0.x = cvtpk(o0[4 * g] * inv, o0[4 * g + 1] * inv); w0.y = cvtpk(o0[4 * g + 2] * inv, o0[4 * g + 3] * inv);
        w1.x = cvtpk(o1[4 * g] * inv, o1[4 * g + 1] * inv); w1.y = cvtpk(o1[4 * g + 2] * inv, o1[4 * g + 3] * inv);
        *(u32x2*)(op + 8 * g) = w0; *(u32x2*)(op + 32 + 8 * g) = w1; }
    __syncthreads();
}

DI int chunk_row0(int b, int X) { return X < 2 ? NL + b * 256 + 128 * X : b * 4096 + 128 * (X - 2); }
DI int chunk_key0(int X) { return X < 2 ? SEQ + 128 * X : 128 * (X - 2); }
DI float logsig(float f) { return fminf(f, 0.f) - log1pf(__expf(-fabsf(f))); }
DI void mlstm_a_unit(const Ctx& c, int b, int hd, int X) {
    const int lane = c.lane, r32 = lane & 31, hh = lane >> 5, w = c.wave, dir = w >> 2, vt = w & 3;
    LAS float* wts = (LAS float*)c.lds;
    const int row0 = chunk_row0(b, X), key0 = chunk_key0(X);
    const float* G = wsp<float>(c, WS_GATES);
    const int sidx = ((b * 4 + hd) * 2) * NCHUNK + X;
    if (w == 0 || w == 4) {
        const int u0 = 2 * lane, s0 = dir ? 127 - u0 : u0, s1 = dir ? 126 - u0 : u0 + 1;
        const float i0 = G[(size_t)(row0 + s0) * 16 + (2 * dir) * 4 + hd], f0 = G[(size_t)(row0 + s0) * 16 + (2 * dir + 1) * 4 + hd];
        const float i1 = G[(size_t)(row0 + s1) * 16 + (2 * dir) * 4 + hd], f1 = G[(size_t)(row0 + s1) * 16 + (2 * dir + 1) * 4 + hd];
        const float l0 = logsig(f0), l1 = logsig(f1);
        float v = l0 + l1;
#pragma unroll
        for (int o = 1; o < 64; o <<= 1) { const float t = shup(v, o, lane); if (lane >= o) v += t; }
        const float tot = shidx(v, 63), c1 = v, c0 = v - l1;
        const float wl0 = tot - c0 + i0, wl1 = tot - c1 + i1;
        const float mloc = wave_max(fmaxf(wl0, wl1), lane);
        wts[dir * 128 + s0] = __expf(wl0 - mloc); wts[dir * 128 + s1] = __expf(wl1 - mloc);
        if (lane == 0) { float* sc = wsp<float>(c, WS_SC) + (size_t)(sidx + dir * NCHUNK) * 2; sc[0] = mloc; sc[1] = tot; }
    }
    __syncthreads();
    const bf16_t* MVT = wsp<bf16_t>(c, WS_MVT) + ((size_t)(b * 4 + hd) * 128 + 32 * vt + r32) * KEYS + key0 + 8 * hh;
    const bf16_t* MKT = wsp<bf16_t>(c, WS_MKT) + ((size_t)(b * 4 + hd) * 64 + r32) * KEYS + key0 + 8 * hh;
    f32x16 a0, a1;
#pragma unroll
    for (int i = 0; i < 16; ++i) { a0[i] = 0.f; a1[i] = 0.f; }
#pragma unroll
    for (int ks = 0; ks < 8; ++ks) {
        const u32x4 vr = *(const u32x4*)(MVT + 16 * ks); const LAS float* wp = wts + dir * 128 + 16 * ks + 8 * hh;
        const bf16x8 af = pack8(bflo(vr.x) * wp[0], bfhi(vr.x) * wp[1], bflo(vr.y) * wp[2], bfhi(vr.y) * wp[3], bflo(vr.z) * wp[4], bfhi(vr.z) * wp[5], bflo(vr.w) * wp[6], bfhi(vr.w) * wp[7]);
        const bf16x8 b0 = *(const bf16x8*)(MKT + 16 * ks), b1 = *(const bf16x8*)(MKT + (size_t)32 * KEYS + 16 * ks);
        a0 = MFMA32(af, b0, a0); a1 = MFMA32(af, b1, a1);
    }
    bf16_t* Cp = wsp<bf16_t>(c, WS_STC) + (size_t)(sidx + dir * NCHUNK) * 8192;
#pragma unroll
    for (int i = 0; i < 16; ++i) { const int v = 32 * vt + crow(i, hh); Cp[v * 64 + r32] = f2bf(a0[i]); Cp[v * 64 + 32 + r32] = f2bf(a1[i]); }
    if (c.tid < 128) { const int d2 = c.tid >> 6, k = c.tid & 63; const bf16_t* kp = wsp<bf16_t>(c, WS_MKT) + ((size_t)(b * 4 + hd) * 64 + k) * KEYS + key0; float s = 0.f;
        for (int q = 0; q < 16; ++q) { const u32x4 kr = *(const u32x4*)(kp + 8 * q); const LAS float* wp = wts + d2 * 128 + 8 * q;
            s += bflo(kr.x) * wp[0] + bfhi(kr.x) * wp[1] + bflo(kr.y) * wp[2] + bfhi(kr.y) * wp[3] + bflo(kr.z) * wp[4] + bfhi(kr.z) * wp[5] + bflo(kr.w) * wp[6] + bfhi(kr.w) * wp[7]; }
        wsp<float>(c, WS_STN)[(size_t)(sidx + d2 * NCHUNK) * 64 + k] = s; }
    __syncthreads();
}
DI void mlstm_b_unit(const Ctx& c, int bu) {
    const int seq = bu >> 3, part = bu & 7, dir = seq & 1; const int e2 = part * 512 + c.tid;
    unsigned* Cb = wsp<unsigned>(c, WS_STC) + (size_t)seq * NCHUNK * 4096 + e2;
    const float* SCp = wsp<float>(c, WS_SC) + (size_t)seq * NCHUNK * 2; float* MSp = wsp<float>(c, WS_MS) + (size_t)seq * NCHUNK; float* Np = wsp<float>(c, WS_STN) + (size_t)seq * NCHUNK * 64;
    float C0 = 0.f, C1 = 0.f, m = 0.f, nv = 0.f; const bool don = (part == 0 && c.tid < 64);
    for (int j = 0; j < NCHUNK; ++j) { const int X = dir == 0 ? j : (j < 2 ? 1 - j : 35 - j);
        const float mloc = SCp[2 * X], tot = SCp[2 * X + 1];
        const unsigned cl = Cb[(size_t)X * 4096]; Cb[(size_t)X * 4096] = cvtpk(C0, C1);
        const float mnew = fmaxf(tot + m, mloc), dec = __expf(tot + m - mnew), sc = __expf(mloc - mnew);
        C0 = dec * C0 + sc * bflo(cl); C1 = dec * C1 + sc * bfhi(cl);
        if (don) { const float nl = Np[X * 64 + c.tid]; Np[X * 64 + c.tid] = nv; nv = dec * nv + sc * nl; }
        if (part == 0 && c.tid == 0) MSp[X] = m;
        m = mnew; }
}
DI void mlstm_c_unit(const Ctx& c, const float* gml_l, int b, int hd, int X) {
    const int lane = c.lane, r32 = lane & 31, hh = lane >> 5, w = c.wave, dir = w >> 2, tt = w & 3;
    LAS float* cs_ = (LAS float*)c.lds;
    LAS float* gs_ = cs_ + 256;
    LAS float* Ms_ = gs_ + 256;
    LAS float* ns_ = Ms_ + 256;
    LAS float* XH = ns_ + 128;
    const int row0 = chunk_row0(b, X), key0 = chunk_key0(X);
    const int sidx = ((b * 4 + hd) * 2 + dir) * NCHUNK + X;
    const float mstart = wsp<float>(c, WS_MS)[sidx];
    if (w == 0 || w == 4) {
        const float* G = wsp<float>(c, WS_GATES);
        const int u0 = 2 * lane, s0 = dir ? 127 - u0 : u0, s1 = dir ? 126 - u0 : u0 + 1;
        const float i0 = G[(size_t)(row0 + s0) * 16 + (2 * dir) * 4 + hd], f0 = G[(size_t)(row0 + s0) * 16 + (2 * dir + 1) * 4 + hd];
        const float i1 = G[(size_t)(row0 + s1) * 16 + (2 * dir) * 4 + hd], f1 = G[(size_t)(row0 + s1) * 16 + (2 * dir + 1) * 4 + hd];
        const float l0 = logsig(f0), l1 = logsig(f1);
        float v = l0 + l1;
#pragma unroll
        for (int o = 1; o < 64; o <<= 1) { const float t = shup(v, o, lane); if (lane >= o) v += t; }
        const float c1 = v, c0 = v - l1, g0 = i0 - c0, g1 = i1 - c1;
        float mxv = fmaxf(g0, g1);
#pragma unroll
        for (int o = 1; o < 64; o <<= 1) { const float t = shup(mxv, o, lane); if (lane >= o) mxv = fmaxf(mxv, t); }
        float pre = shup(mxv, 1, lane); if (lane == 0) pre = -INFINITY;
        const float M0 = fmaxf(mstart, fmaxf(pre, g0)), M1 = fmaxf(mstart, mxv);
        cs_[dir * 128 + s0] = c0; cs_[dir * 128 + s1] = c1; gs_[dir * 128 + s0] = g0; gs_[dir * 128 + s1] = g1; Ms_[dir * 128 + s0] = M0; Ms_[dir * 128 + s1] = M1;
        ns_[dir * 64 + lane] = wsp<float>(c, WS_STN)[(size_t)sidx * 64 + lane];
    }
    __syncthreads();
    const int t = 32 * tt + r32;
    const bf16_t* qp = wsp<bf16_t>(c, WS_MQ) + (size_t)(row0 + t) * 256 + hd * 64 + 8 * hh;
    bf16x8 qf[4];
#pragma unroll
    for (int kk = 0; kk < 4; ++kk) qf[kk] = *(const bf16x8*)(qp + 16 * kk);
    const float Mt = Ms_[dir * 128 + t], ct = cs_[dir * 128 + t], at = __expf(mstart - Mt);
    f32x16 acc[4];
    const bf16_t* Cp = wsp<bf16_t>(c, WS_STC) + (size_t)sidx * 8192 + (size_t)r32 * 64 + 8 * hh;
#pragma unroll
    for (int vt = 0; vt < 4; ++vt) {
#pragma unroll
        for (int i = 0; i < 16; ++i) acc[vt][i] = 0.f;
#pragma unroll
        for (int kk = 0; kk < 4; ++kk) acc[vt] = MFMA32(*(const bf16x8*)(Cp + vt * 2048 + 16 * kk), qf[kk], acc[vt]);
#pragma unroll
        for (int i = 0; i < 16; ++i) acc[vt][i] *= at;
    }
    float nq = 0.f;
#pragma unroll
    for (int kk = 0; kk < 4; ++kk) { const u32x4 qw = __builtin_bit_cast(u32x4, qf[kk]); const LAS float* np = ns_ + dir * 64 + 16 * kk + 8 * hh;
        nq += bflo(qw.x) * np[0] + bfhi(qw.x) * np[1] + bflo(qw.y) * np[2] + bfhi(qw.y) * np[3] + bflo(qw.z) * np[4] + bfhi(qw.z) * np[5] + bflo(qw.w) * np[6] + bfhi(qw.w) * np[7]; }
    nq += shx(nq, 32, lane);
    float dsum = 0.f;
    const bf16_t* kbase = wsp<bf16_t>(c, WS_MK) + (size_t)(row0 + r32) * 256 + hd * 64 + 8 * hh;
    const bf16_t* vbase = wsp<bf16_t>(c, WS_MVT) + ((size_t)(b * 4 + hd) * 128 + r32) * KEYS + key0 + 4 * hh;
    for (int st = 0; st < 4; ++st) {
        if (dir == 0 ? st > tt : st < tt) continue;
        f32x16 s;
#pragma unroll
        for (int i = 0; i < 16; ++i) s[i] = 0.f;
#pragma unroll
        for (int kk = 0; kk < 4; ++kk) s = MFMA32(*(const bf16x8*)(kbase + (size_t)32 * st * 256 + 16 * kk), qf[kk], s);
#pragma unroll
        for (int i = 0; i < 16; ++i) { const int si = 32 * st + crow(i, hh); const bool ok = dir == 0 ? si <= t : si >= t; const float d = __expf(gs_[dir * 128 + si] - Mt);
            const float val = ok ? s[i] * d : 0.f; s[i] = val; dsum += val; }
        const bf16x8 p0 = pack8(s[0], s[1], s[2], s[3], s[4], s[5], s[6], s[7]), p1 = pack8(s[8], s[9], s[10], s[11], s[12], s[13], s[14], s[15]);
#pragma unroll
        for (int vt = 0; vt < 4; ++vt) { const bf16_t* vp = vbase + (size_t)32 * vt * KEYS + 32 * st;
            { const s16x4 lo = *(const s16x4*)vp, hi = *(const s16x4*)(vp + 8); acc[vt] = MFMA32(__builtin_shufflevector(lo, hi, 0, 1, 2, 3, 4, 5, 6, 7), p0, acc[vt]); }
            { const s16x4 lo = *(const s16x4*)(vp + 16), hi = *(const s16x4*)(vp + 24); acc[vt] = MFMA32(__builtin_shufflevector(lo, hi, 0, 1, 2, 3, 4, 5, 6, 7), p1, acc[vt]); } }
    }
    dsum += shx(dsum, 32, lane);
    const float den = at * nq + dsum, dn = fmaxf(fabsf(den), __expf(-(ct + Mt))), rdn = 1.f / dn;
#pragma unroll
    for (int vt = 0; vt < 4; ++vt)
#pragma unroll
        for (int i = 0; i < 16; ++i) acc[vt][i] *= rdn;
    if (dir == 1) {
#pragma unroll
        for (int vt = 0; vt < 4; ++vt)
#pragma unroll
            for (int i = 0; i < 16; ++i) XH[(tt * 128 + 32 * vt + crow(i, hh)) * 32 + r32] = acc[vt][i];
    }
    __syncthreads();
    if (dir == 0) {
        float ss = 0.f;
#pragma unroll
        for (int vt = 0; vt < 4; ++vt)
#pragma unroll
            for (int i = 0; i < 16; ++i) { acc[vt][i] += XH[(tt * 128 + 32 * vt + crow(i, hh)) * 32 + r32]; ss += acc[vt][i] * acc[vt][i]; }
        ss += shx(ss, 32, lane);
        const float rs = rsqrtf(ss * (1.f / 128.f) + EPS);
        bf16_t* mo = wsp<bf16_t>(c, WS_MO) + (size_t)(row0 + t) * 512 + hd * 128 + 4 * hh; const float* gm = gml_l + hd * 128 + 4 * hh;
#pragma unroll
        for (int vt = 0; vt < 4; ++vt)
#pragma unroll
            for (int g = 0; g < 4; ++g) { const int v = 32 * vt + 8 * g; const u32x2 ow = *(const u32x2*)(mo + v); const f32x4 gg = *(const f32x4*)(gm + v);
                const float h0 = acc[vt][4 * g] * rs * gg.x * sigmoidf_(bflo(ow.x)), h1 = acc[vt][4 * g + 1] * rs * gg.y * sigmoidf_(bfhi(ow.x));
                const float h2 = acc[vt][4 * g + 2] * rs * gg.z * sigmoidf_(bflo(ow.y)), h3 = acc[vt][4 * g + 3] * rs * gg.w * sigmoidf_(bfhi(ow.y));
                u32x2 o; o.x = cvtpk(h0, h1); o.y = cvtpk(h2, h3); *(u32x2*)(mo + v) = o; }
    }
    __syncthreads();
}

constexpr int LDS_BYTES = 147456;
constexpr int MISC_OFF = 131072 + 320;
__global__ void __launch_bounds__(512, 2) mk_fwd(Params p) {
    extern __shared__ __attribute__((aligned(16))) unsigned char lds_raw[];
    Ctx c; c.in = p.in; c.out = p.out; c.ws = p.ws; c.lds = (LAS unsigned char*)lds_raw;
    c.tid = threadIdx.x; c.lane = c.tid & 63; c.wave = __builtin_amdgcn_readfirstlane(c.tid >> 6);
    c.G = gridDim.x; { const int bx = blockIdx.x; c.vcu = (c.G % 8 == 0) ? (bx % 8) * (c.G / 8) + bx / 8 : bx; }
    volatile LAS unsigned* MISC = (volatile LAS unsigned*)(c.lds + MISC_OFF);
    for (int u = c.tid; u < 64; u += 512) ((LAS unsigned*)(c.lds + 131072))[u + 80] = 0u;
    if (c.tid < 80) ((LAS unsigned*)(c.lds + 131072))[c.tid] = 0u;
    __syncthreads();
    XcdBarrier bar; bar.bar = (unsigned*)(c.ws + WS_CTL) + CW_BAR; bar.x = 0; bar.st = nullptr;
    const bool multi = (p.ph_hi - p.ph_lo) > 1;
    if (multi) bar = xcd_barrier_post((unsigned*)(c.ws + WS_CTL) + CW_BAR, MISC + 8);

#define RELAUNDER() do { int t_ = threadIdx.x; asm volatile("" : "+v"(t_)); c.tid = t_; c.lane = t_ & 63; unsigned char* w_ = p.ws; asm volatile("" : "+s"(w_)); c.ws = w_; float* o_ = p.out; asm volatile("" : "+s"(o_)); c.out = o_; } while (0)
    for (int ph = p.ph_lo; ph < p.ph_hi; ++ph) {
        RELAUNDER();
        if (ph == 0) { if (PHON(0)) phase_A(c); }
        else if (ph == 1) { if (PHON(1)) phase_B(c); }
        else {
            const int l = (ph - 2) / 13, k = (ph - 2) % 13;
            unsigned char* sw = c.ws + WS_SW + (size_t)l * SW_STRIDE;
            if (k == 0 && PHON(2)) {
                pg8::Order S; S.init(NT / 256, 23, c.G, (int)blockIdx.x, c.ws + WS_HBUF, 1024, sw + SW_WIN, 1024, 0);
                EpiG1 E{c.ws, c.in[I_BML] + l * 16, wsp<float>(c, WS_ROPE)};
                pg8::gemm_phase<EpiG1, pg8::Order, true>(c.lds, pg8::Gemm{1024, 1024, 1024}, S, E, c.tid);
            } else if (k == 1 && PHON(3)) {
                pg8::Order S; S.init(NT / 256, 4, c.G, (int)blockIdx.x, c.ws + WS_CQKV, 384, sw + SW_WQKV, 384, 0);
                EpiG2 E{c.ws, wsp<float>(c, WS_ROPE)};
                pg8::gemm_phase<EpiG2, pg8::Order, true>(c.lds, pg8::Gemm{384, 384, 384}, S, E, c.tid);
                __syncthreads(); RELAUNDER();
                for (int u = c.G - 1 - c.vcu; u < NB * 4 * NCHUNK; u += c.G) mlstm_a_unit(c, u / (4 * NCHUNK), (u / NCHUNK) & 3, u % NCHUNK);
            } else if (k == 2 && PHON(4)) {
                const int nmla = (l == 0) ? 544 : 512, nna = nmla, ntot = nmla + nna + 512;
                for (int u = c.vcu; u < ntot; u += c.G) {
                    if (u < nmla) { if (u < 512) { const int b = u >> 6, hd = (u >> 4) & 3, qb = u & 15; mla_unit(c, b, hd, b * 4096 + qb * 256, 0, 68); }
                                    else { const int v = u - 512, b = v >> 2, hd = v & 3; mla_unit(c, b, hd, NL + b * 256, 64, 68); } }
                    else if (u < nmla + nna) { const int v = u - nmla; if (v < 512) { const int b = v >> 6, hd = (v >> 4) & 3, rb = v & 15; na_unit(c, c.in[I_RPB] + (size_t)l * 4 * 465, b, hd, rb * 4); }
                                    else { const int q = v - 512, b = q >> 2, hd = q & 3; na_unit(c, c.in[I_RPB] + (size_t)l * 4 * 465, b, hd, -1); } }
                    else mlstm_b_unit(c, u - nmla - nna);
                }
            } else if (k == 3 && PHON(5)) {
                const int x0 = (l == 0) ? 0 : 2, nx = NCHUNK - x0;
                for (int u = c.vcu; u < NB * 4 * nx; u += c.G) mlstm_c_unit(c, c.in[I_GML] + l * 512, u / (4 * nx), (u / nx) & 3, x0 + u % nx);
            } else if (k == 4 && PHON(6)) {
                const int nM = ((l == 0) ? NT : NL) / 256;
                for (int br = 0; br < 3; ++br) {
                    RELAUNDER();
                    const void* A = br == 0 ? (const void*)(c.ws + WS_CQKV) : br == 1 ? (const void*)(c.ws + WS_NQ) : (const void*)(c.ws + WS_MO);
                    const void* Bw = br == 0 ? (const void*)(sw + SW_WA) : br == 1 ? (const void*)(sw + SW_WB) : (const void*)(sw + SW_WM);
                    const int kk = br == 2 ? 512 : 256;
                    pg8::Order S; S.init(nM, 4, c.G, (int)blockIdx.x, A, kk, Bw, kk, 0);
                    EpiStore E{wsp<bf16_t>(c, WS_P) + br * 1024, 3072};
                    pg8::gemm_phase<EpiStore, pg8::Order, true>(c.lds, pg8::Gemm{kk, kk, kk}, S, E, c.tid);
                }
            } else if (k == 5) { if (PHON(7)) phase_combine(c, l); }
            else if (k == 6 && PHON(8)) {
                const int nM = ((l == 0) ? NT : NL) / 256;
                pg8::Order S; S.init(nM, 4, c.G, (int)blockIdx.x, c.ws + WS_P, 3072, sw + SW_WOUT, 1024, 0);
                EpiStore E{wsp<bf16_t>(c, WS_YO), 1024};
                pg8::gemm_phase<EpiStore, pg8::Order, true>(c.lds, pg8::Gemm{3072, 1024, 1024}, S, E, c.tid);
            } else if (k == 7) { if (PHON(9)) phase_rows1(c, l); }
            else if (k == 8) { if (PHON(10)) phase_topk(c, l); }
            else if (k == 9) { if (PHON(11)) phase_gather(c, l); }
            else if (k == 10 && PHON(12)) {
                const int nM = (l == 0) ? 272 : 256;
                pg8::Order S; S.init(nM, 8, c.G, (int)blockIdx.x, c.ws + WS_XS, 1024, c.ws + WS_W13, 1024, 1);
                EpiMoe1 E{wsp<bf16_t>(c, WS_HID)};
                pg8::gemm_phase<EpiMoe1, pg8::Order, true>(c.lds, pg8::Gemm{1024, 1024, 1024}, S, E, c.tid);
            } else if (k == 11 && PHON(13)) {
                const int nM = (l == 0) ? 272 : 256;
                pg8::Order S; S.init(nM, 4, c.G, (int)blockIdx.x, c.ws + WS_HID, 1024, c.ws + WS_W2, 1024, 1);
                EpiStore E{wsp<bf16_t>(c, WS_XS), 1024};
                pg8::gemm_phase<EpiStore, pg8::Order, true>(c.lds, pg8::Gemm{1024, 1024, 1024}, S, E, c.tid);
            } else if (k == 12 && PHON(14)) phase_rows2(c, l);
        }
        if (ph + 1 < p.ph_hi) xcd_barrier(bar);
    }
}

extern "C" void kernel_launch(void* const* d_in, const int* in_sizes, int n_in, void* d_out, int out_size, void* d_ws, size_t ws_size, hipStream_t stream) {
    static int grid = 0;
    if (grid == 0) {
        if (n_in != 26 || out_size != NL * DM || ws_size < WS_END) { fprintf(stderr, "kernel_launch: unexpected problem (n_in %d out %d ws %zu, need %zu)\n", n_in, out_size, ws_size, (size_t)WS_END); grid = -1; return; }
        int dev = 0, cus = 0;
        if (hipGetDevice(&dev) != hipSuccess || hipDeviceGetAttribute(&cus, hipDeviceAttributeMultiprocessorCount, dev) != hipSuccess) { grid = -1; return; }
        if (hipFuncSetAttribute((const void*)mk_fwd, hipFuncAttributeMaxDynamicSharedMemorySize, LDS_BYTES) != hipSuccess) { fprintf(stderr, "kernel_launch: hipFuncSetAttribute failed\n"); grid = -1; return; }
        int per_cu = 0;
        if (hipOccupancyMaxActiveBlocksPerMultiprocessor(&per_cu, (const void*)mk_fwd, 512, LDS_BYTES) != hipSuccess || per_cu < 1) fprintf(stderr, "kernel_launch: occupancy query says %d\n", per_cu);
        (void)hipGetLastError();
        grid = cus;
    }
    if (grid < 0) return;
    (void)hipMemsetAsync((char*)d_ws + WS_CTL, 0, CTL_ZERO_BYTES, stream);
    Params a{};
    for (int i = 0; i < 26; ++i) a.in[i] = (const float*)d_in[i];
    a.out = (float*)d_out; a.ws = (unsigned char*)d_ws;
#if MK_PER_PHASE
    for (int ph = 0; ph < NPHASE; ++ph) { a.ph_lo = ph; a.ph_hi = ph + 1; hipLaunchKernelGGL(mk_fwd, dim3(grid), dim3(512), LDS_BYTES, stream, a); }
#else
    a.ph_lo = 0; a.ph_hi = NPHASE;
    hipLaunchKernelGGL(mk_fwd, dim3(grid), dim3(512), LDS_BYTES, stream, a);
#endif
}
```
